# Optimizing an MI355X kernel written in HIP

```python
import math
import jax, jax.numpy as jnp
from jax import lax
import numpy as np

D_MODEL = 1024
BATCH = 16
SEQ = 2048
DEPTH = 2

PLE_DIM = 256
ATTN_HEADS = 16
HEAD_DIM = 64
ATTN_WIDTH = ATTN_HEADS * HEAD_DIM
POOL_WINDOWS = (2, 4, 8, 16)
N_POOL_GROUPS = len(POOL_WINDOWS)
POOL_GROUP_DIM = 256
POOL_WIDTH = N_POOL_GROUPS * POOL_GROUP_DIM
MIX_WIDTH = ATTN_WIDTH + POOL_WIDTH
Q_BLOCK = 128
EPS = 1e-6
SPLIT_SIZES = (ATTN_WIDTH, ATTN_WIDTH, ATTN_WIDTH, ATTN_WIDTH, ATTN_HEADS, POOL_WIDTH, POOL_WIDTH)
IN_COLS = sum(SPLIT_SIZES)
SPLIT_POINTS = tuple(int(v) for v in np.cumsum(SPLIT_SIZES)[:-1])

kernel_name = "hymba_fox_pool_hybrid"


def rms_norm(x, g):
    xf = x.astype(jnp.float32)
    y = xf * lax.rsqrt(jnp.mean(xf * xf, axis=-1, keepdims=True) + EPS)
    return (y * g.astype(jnp.float32)).astype(x.dtype)


def multi_scale_pool(u, w_pool, pool_scale):
    B, S, _ = u.shape
    ug = u.reshape(B, S, N_POOL_GROUPS, POOL_GROUP_DIM).astype(jnp.float32)
    cs = jnp.cumsum(ug, axis=1)
    pos = jnp.arange(1, S + 1, dtype=jnp.float32)
    outs = []
    for g, w in enumerate(POOL_WINDOWS):
        c = cs[:, :, g]
        shifted = jnp.pad(c, ((0, 0), (w, 0), (0, 0)))[:, :S]
        count = jnp.minimum(pos, float(w))[None, :, None]
        outs.append((c - shifted) / count - ug[:, :, g])
    pooled = jnp.stack(outs, axis=2).astype(u.dtype)
    mixed = jnp.einsum('bsgc,gcd->bsgd', pooled, w_pool)
    return mixed.reshape(B, S, POOL_WIDTH) * pool_scale


def forgetting_attention(q, k, v, log_f):
    B, S, H, Dh = q.shape
    scale = 1.0 / math.sqrt(Dh)
    c = jnp.cumsum(log_f, axis=1).transpose(0, 2, 1)
    qh = q.transpose(0, 2, 1, 3)
    kh = k.transpose(0, 2, 1, 3)
    vh = v.transpose(0, 2, 1, 3)
    tri = jnp.tril(jnp.ones((Q_BLOCK, Q_BLOCK), dtype=bool))
    outs = []
    for i in range(S // Q_BLOCK):
        q0 = i * Q_BLOCK
        end = q0 + Q_BLOCK
        qb = qh[:, :, q0:end]
        kb = kh[:, :, :end]
        vb = vh[:, :, :end]
        s = jnp.einsum('bhqd,bhkd->bhqk', qb, kb,
                       preferred_element_type=jnp.float32) * scale
        s = s + c[:, :, q0:end, None] - c[:, :, None, :end]
        mask = jnp.concatenate([jnp.ones((Q_BLOCK, q0), dtype=bool), tri], axis=1)
        s = jnp.where(mask[None, None], s, -jnp.inf)
        pr = jax.nn.softmax(s, axis=-1)
        outs.append(jnp.einsum('bhqk,bhkd->bhqd', pr.astype(v.dtype), vb))
    o = jnp.concatenate(outs, axis=2)
    return o.transpose(0, 2, 1, 3)


def setup_inputs(seed: int = 0) -> dict:
    key = jax.random.key(seed)
    ks = jax.random.split(key, 12)
    f32 = jnp.float32
    x = jax.random.normal(ks[0], (BATCH, SEQ, D_MODEL), f32)
    p = jax.random.normal(ks[1], (DEPTH, BATCH, SEQ, PLE_DIM), f32)
    norm_pre = 1.0 + 0.05 * jax.random.normal(ks[2], (DEPTH, D_MODEL), f32)
    norm_post = 1.0 + 0.05 * jax.random.normal(ks[3], (DEPTH, D_MODEL), f32)
    w_in = jax.random.normal(ks[4], (DEPTH, D_MODEL, IN_COLS), f32) * D_MODEL ** -0.5
    b_f = 3.0 + 0.5 * jax.random.normal(ks[5], (DEPTH, ATTN_HEADS), f32)
    w_pool = jax.random.normal(ks[6], (DEPTH, N_POOL_GROUPS, POOL_GROUP_DIM, POOL_GROUP_DIM), f32) * POOL_GROUP_DIM ** -0.5
    pool_scale = 1.0 + 0.1 * jax.random.normal(ks[7], (DEPTH, POOL_WIDTH), f32)
    w_out = jax.random.normal(ks[8], (DEPTH, MIX_WIDTH, D_MODEL), f32) * MIX_WIDTH ** -0.5
    w_pg = jax.random.normal(ks[9], (DEPTH, D_MODEL, D_MODEL), f32) * D_MODEL ** -0.5
    w_pe = jax.random.normal(ks[10], (DEPTH, PLE_DIM, D_MODEL), f32) * (0.5 * PLE_DIM ** -0.5)
    return {"x": x, "p": p, "norm_pre": norm_pre, "norm_post": norm_post,
            "w_in": w_in, "b_f": b_f, "w_pool": w_pool, "pool_scale": pool_scale,
            "w_out": w_out, "w_pg": w_pg, "w_pe": w_pe}


def reference(x, p, norm_pre, norm_post, w_in, b_f, w_pool, pool_scale, w_out, w_pg, w_pe):
    B, S, _ = x.shape
    h = x
    for i in range(DEPTH):
        hn = rms_norm(h, norm_pre[i])
        proj = hn @ w_in[i]
        q, k, v, z_attn, f_logit, u_pool, z_pool = jnp.split(proj, SPLIT_POINTS, axis=-1)
        log_f = jax.nn.log_sigmoid(f_logit.astype(jnp.float32) + b_f[i].astype(jnp.float32))
        attn = forgetting_attention(
            q.reshape(B, S, ATTN_HEADS, HEAD_DIM),
            k.reshape(B, S, ATTN_HEADS, HEAD_DIM),
            v.reshape(B, S, ATTN_HEADS, HEAD_DIM), log_f)
        attn = attn.reshape(B, S, ATTN_WIDTH) * jax.nn.silu(z_attn)
        pool = multi_scale_pool(u_pool, w_pool[i], pool_scale[i]) * jax.nn.silu(z_pool)
        mix = jnp.concatenate([attn, pool], axis=-1) @ w_out[i]
        h = h + rms_norm(mix, norm_post[i])
        gate = jax.nn.sigmoid(h @ w_pg[i])
        h = h + gate * (p[i] @ w_pe[i])
    return h
```

```cpp
#include <hip/hip_runtime.h>
#include <cstdio>
#include <cstdint>

typedef unsigned short bf16_t;
typedef short bf16x8 __attribute__((ext_vector_type(8)));
typedef float f32x4 __attribute__((ext_vector_type(4)));
typedef unsigned u32x4 __attribute__((ext_vector_type(4)));
typedef unsigned u32x2 __attribute__((ext_vector_type(2)));

constexpr int DM = 1024, BATCH = 16, SEQ = 2048, T = BATCH * SEQ, NH = 16, HD = 64, PLE = 256, DEPTH = 2;
constexpr int INC = 6160;
constexpr int NIN = 6144;
constexpr int MIXW = 2048;
constexpr float EPS = 1e-6f;
constexpr float LOG2E = 1.4426950408889634f;
constexpr float C2 = 0.125f * LOG2E;

constexpr size_t MiB = 1u << 20;
constexpr size_t WS_CTL = 0;
constexpr size_t WS_LF = 1 * MiB;
constexpr size_t WS_CS = 3 * MiB;
constexpr size_t WS_RSS = 5 * MiB;
constexpr size_t WS_WIN = 8 * MiB;
constexpr size_t WS_WF = 32 * MiB;
constexpr size_t WS_WOUT = 33 * MiB;
constexpr size_t WS_WPG = 41 * MiB;
constexpr size_t WS_WPE = 45 * MiB;
constexpr size_t WS_HB = 48 * MiB;
constexpr size_t WS_QZ = 112 * MiB;
constexpr size_t WS_K = 240 * MiB;
constexpr size_t WS_V = 304 * MiB;
constexpr size_t WS_ZA = 368 * MiB;
constexpr size_t WS_Y = 432 * MiB;
constexpr size_t WS_END = 496 * MiB;
constexpr size_t WS_MIX = WS_K;

__device__ __forceinline__ unsigned f2bf(float f) { unsigned u = __builtin_bit_cast(unsigned, f); return (u + 0x7fffu + ((u >> 16) & 1u)) >> 16; }
__device__ __forceinline__ unsigned pk2(float lo, float hi) { return f2bf(lo) | (f2bf(hi) << 16); }
__device__ __forceinline__ float bf2f(unsigned short h) { return __builtin_bit_cast(float, (unsigned)h << 16); }
__device__ __forceinline__ float bflo(unsigned w) { return __builtin_bit_cast(float, w << 16); }
__device__ __forceinline__ float bfhi(unsigned w) { return __builtin_bit_cast(float, w & 0xffff0000u); }
__device__ __forceinline__ float silu_f(float x) { return x / (1.f + __expf(-x)); }
__device__ __forceinline__ float sigmoid_f(float x) { return 1.f / (1.f + __expf(-x)); }
__device__ __forceinline__ float wave_sum(float v) {
#pragma unroll
    for (int o = 1; o < 64; o <<= 1) v += __shfl_xor(v, o);
    return v;
}

__global__ void __launch_bounds__(256) k_transpose(const float* __restrict__ W, int K, int N, int ldn, int n0, const float* __restrict__ gk, bf16_t* __restrict__ dst) {
    __shared__ float scr_all[4][64 * 33];
    const int lane = threadIdx.x & 63, wid = threadIdx.x >> 6;
    float* scr = scr_all[wid];
    const int nblk = N / 32, nitems = (K / 64) * nblk;
    for (int item = blockIdx.x * 4 + wid; item < nitems; item += gridDim.x * 4) {
        const int kb = item / nblk, nb = item % nblk, k0 = 64 * kb, nn0 = 32 * nb;
        for (int i = 0; i < 32; ++i) { const int kk = 2 * i + (lane >> 5); float v = W[(size_t)(k0 + kk) * ldn + n0 + nn0 + (lane & 31)]; if (gk) v *= gk[k0 + kk]; scr[kk * 33 + (lane & 31)] = v; }
        __builtin_amdgcn_s_waitcnt(0xc07f); __builtin_amdgcn_wave_barrier();
        const int c = lane & 7;
        for (int j = 0; j < 4; ++j) { const int n = (lane >> 3) + 8 * j; const float* s = scr + (8 * c) * 33 + n;
            u32x4 o; o.x = pk2(s[0 * 33], s[1 * 33]); o.y = pk2(s[2 * 33], s[3 * 33]); o.z = pk2(s[4 * 33], s[5 * 33]); o.w = pk2(s[6 * 33], s[7 * 33]);
            *(u32x4*)(dst + (size_t)(nn0 + n) * K + k0 + 8 * c) = o; }
        __builtin_amdgcn_s_waitcnt(0xc07f); __builtin_amdgcn_wave_barrier();
    }
}
__global__ void k_fcols(const float* __restrict__ W, const float* __restrict__ gk, bf16_t* __restrict__ dst) {
    const int i = blockIdx.x * blockDim.x + threadIdx.x; if (i >= 16 * DM) return;
    const int n = i / DM, k = i % DM; dst[i] = (bf16_t)f2bf(gk[k] * W[(size_t)k * INC + 4096 + n]);
}
__global__ void __launch_bounds__(256) k_poolfold(const float* __restrict__ W, const float* __restrict__ P, const float* __restrict__ gk, bf16_t* __restrict__ dst) {
    __shared__ float As[16][65], Bs[16][64];
    const int g = blockIdx.z, k0 = blockIdx.y * 64, n0 = blockIdx.x * 64, tid = threadIdx.x, tx = tid & 15, ty = tid >> 4;
    float acc[4][4] = {};
    for (int j0 = 0; j0 < 256; j0 += 16) {
        for (int i = tid; i < 64 * 16; i += 256) { const int kk = i >> 4, jj = i & 15; As[jj][kk] = W[(size_t)(k0 + kk) * INC + 4112 + 256 * g + j0 + jj]; }
        for (int i = tid; i < 16 * 64; i += 256) { const int jj = i >> 6, nn = i & 63; Bs[jj][nn] = P[((size_t)g * 256 + j0 + jj) * 256 + n0 + nn]; }
        __syncthreads();
#pragma unroll
        for (int jj = 0; jj < 16; ++jj) { float a[4], b[4];
#pragma unroll
            for (int i = 0; i < 4; ++i) { a[i] = As[jj][ty * 4 + i]; b[i] = Bs[jj][tx * 4 + i]; }
#pragma unroll
            for (int i = 0; i < 4; ++i)
#pragma unroll
                for (int q = 0; q < 4; ++q) acc[i][q] += a[i] * b[q]; }
        __syncthreads();
    }
    float gs[4];
#pragma unroll
    for (int i = 0; i < 4; ++i) gs[i] = gk[k0 + ty * 4 + i];
#pragma unroll
    for (int q = 0; q < 4; ++q) { u32x2 o; o.x = pk2(acc[0][q] * gs[0], acc[1][q] * gs[1]); o.y = pk2(acc[2][q] * gs[2], acc[3][q] * gs[3]);
        *(u32x2*)(dst + (size_t)(4096 + 256 * g + n0 + tx * 4 + q) * DM + k0 + ty * 4) = o; }
}
__global__ void __launch_bounds__(256) k_rows_bf16(const float* __restrict__ x, bf16_t* __restrict__ xb, float* __restrict__ rss, int rows) {
    const int lane = threadIdx.x & 63; const int gw = blockIdx.x * 4 + (threadIdx.x >> 6), ngw = gridDim.x * 4;
    for (int m = gw; m < rows; m += ngw) {
        const f32x4* xr = (const f32x4*)(x + (size_t)m * DM) + lane; float s = 0.f; f32x4 v[4];
#pragma unroll
        for (int j = 0; j < 4; ++j) { v[j] = xr[64 * j]; s += (v[j].x * v[j].x + v[j].y * v[j].y) + (v[j].z * v[j].z + v[j].w * v[j].w); }
        s = wave_sum(s);
        if (xb) { u32x2* o = (u32x2*)(xb + (size_t)m * DM) + lane;
#pragma unroll
            for (int j = 0; j < 4; ++j) { u32x2 w; w.x = pk2(v[j].x, v[j].y); w.y = pk2(v[j].z, v[j].w); o[64 * j] = w; } }
        if (lane == 0) rss[m] = s;
    }
}
__global__ void k_cvt(const float* __restrict__ src, bf16_t* __restrict__ dst, size_t n4) {
    for (size_t i = blockIdx.x * (size_t)blockDim.x + threadIdx.x; i < n4; i += (size_t)gridDim.x * blockDim.x) { const f32x4 v = ((const f32x4*)src)[i]; u32x2 w; w.x = pk2(v.x, v.y); w.y = pk2(v.z, v.w); ((u32x2*)dst)[i] = w; }
}

template <class Epi>
__global__ void __launch_bounds__(256) k_gemm(const bf16_t* __restrict__ A, int lda, const bf16_t* __restrict__ Bt, int ldb, int K, Epi epi) {
    __shared__ __attribute__((aligned(16))) bf16_t As[128 * 40];
    __shared__ __attribute__((aligned(16))) bf16_t Bs[128 * 40];
    const int tid = threadIdx.x, lane = tid & 63, wid = tid >> 6, wr = wid >> 1, wc = wid & 1, fr = lane & 15, fq = lane >> 4;
    const int m0 = blockIdx.y * 128, n0 = blockIdx.x * 128;
    f32x4 acc[4][4];
#pragma unroll
    for (int i = 0; i < 4; ++i)
#pragma unroll
        for (int j = 0; j < 4; ++j) acc[i][j] = (f32x4){0.f, 0.f, 0.f, 0.f};
    for (int k0 = 0; k0 < K; k0 += 32) {
#pragma unroll
        for (int i = 0; i < 2; ++i) { const int row = (tid >> 2) + 64 * i, kc = tid & 3;
            const u32x4 a = *(const u32x4*)(A + (size_t)(m0 + row) * lda + k0 + kc * 8);
            const u32x4 b = *(const u32x4*)(Bt + (size_t)(n0 + row) * ldb + k0 + kc * 8);
            *(u32x4*)(As + row * 40 + kc * 8) = a; *(u32x4*)(Bs + row * 40 + kc * 8) = b; }
        __syncthreads();
        bf16x8 af[4], bfr[4];
#pragma unroll
        for (int i = 0; i < 4; ++i) { af[i] = *(const bf16x8*)(As + (wr * 64 + i * 16 + fr) * 40 + fq * 8); bfr[i] = *(const bf16x8*)(Bs + (wc * 64 + i * 16 + fr) * 40 + fq * 8); }
#pragma unroll
        for (int i = 0; i < 4; ++i)
#pragma unroll
            for (int j = 0; j < 4; ++j) acc[i][j] = __builtin_amdgcn_mfma_f32_16x16x32_bf16(bfr[j], af[i], acc[i][j], 0, 0, 0);
        __syncthreads();
    }
#pragma unroll
    for (int i = 0; i < 4; ++i)
#pragma unroll
        for (int j = 0; j < 4; ++j) epi(m0 + wr * 64 + i * 16 + fr, n0 + wc * 64 + j * 16 + 4 * fq, acc[i][j]);
}

__device__ __forceinline__ void st_bf16x4(bf16_t* p, f32x4 v) { u32x2 w; w.x = pk2(v.x, v.y); w.y = pk2(v.z, v.w); *(u32x2*)p = w; }

struct EpiIn {
    const float* rss; bf16_t *QZ, *Kb, *Vb, *ZA, *Y; const float* pscale;
    __device__ __forceinline__ void operator()(int row, int col, f32x4 v) const {
        const float rstd = rsqrtf(rss[row] * (1.f / DM) + EPS);
        const int seg = col >> 10, c = col & 1023;
        v = v * rstd;
        if (seg == 0) { v = v * C2; st_bf16x4(QZ + (size_t)row * 2048 + c, v); }
        else if (seg == 1) st_bf16x4(Kb + (size_t)row * DM + c, v);
        else if (seg == 2) st_bf16x4(Vb + (size_t)row * DM + c, v);
        else if (seg == 3) { v.x = silu_f(v.x); v.y = silu_f(v.y); v.z = silu_f(v.z); v.w = silu_f(v.w); st_bf16x4(ZA + (size_t)row * DM + c, v); }
        else if (seg == 4) st_bf16x4(Y + (size_t)row * DM + c, v);
        else { const f32x4 ps = *(const f32x4*)(pscale + c); v.x = silu_f(v.x) * ps.x; v.y = silu_f(v.y) * ps.y; v.z = silu_f(v.z) * ps.z; v.w = silu_f(v.w) * ps.w; st_bf16x4(QZ + (size_t)row * 2048 + 1024 + c, v); }
    }
};
struct EpiF32 { float* O; int ldc; __device__ __forceinline__ void operator()(int row, int col, f32x4 v) const { *(f32x4*)(O + (size_t)row * ldc + col) = v; } };
struct EpiBf { bf16_t* O; int ldc; __device__ __forceinline__ void operator()(int row, int col, f32x4 v) const { st_bf16x4(O + (size_t)row * ldc + col, v); } };
struct EpiGate {
    float* out; const bf16_t* PE; bf16_t* HB;
    __device__ __forceinline__ void operator()(int row, int col, f32x4 v) const {
        const size_t off = (size_t)row * DM + col; const f32x4 h1 = *(const f32x4*)(out + off); const u32x2 pw = *(const u32x2*)(PE + off);
        f32x4 h2; h2.x = h1.x + sigmoid_f(v.x) * bflo(pw.x); h2.y = h1.y + sigmoid_f(v.y) * bfhi(pw.x); h2.z = h1.z + sigmoid_f(v.z) * bflo(pw.y); h2.w = h1.w + sigmoid_f(v.w) * bfhi(pw.y);
        *(f32x4*)(out + off) = h2; st_bf16x4(HB + off, h2);
    }
};

__global__ void __launch_bounds__(256) k_flogit(const bf16_t* __restrict__ HB, const bf16_t* __restrict__ WF, const float* __restrict__ rss, const float* __restrict__ bfv, float* __restrict__ LF) {
    const int r = threadIdx.x >> 4, hd = threadIdx.x & 15, t = blockIdx.x * 16 + r;
    const u32x4* a = (const u32x4*)(HB + (size_t)t * DM); const u32x4* w = (const u32x4*)(WF + (size_t)hd * DM);
    float s = 0.f;
    for (int i = 0; i < DM / 8; ++i) { const u32x4 av = a[i], wv = w[i];
        s += bflo(av.x) * bflo(wv.x) + bfhi(av.x) * bfhi(wv.x) + bflo(av.y) * bflo(wv.y) + bfhi(av.y) * bfhi(wv.y) + bflo(av.z) * bflo(wv.z) + bfhi(av.z) * bfhi(wv.z) + bflo(av.w) * bflo(wv.w) + bfhi(av.w) * bfhi(wv.w); }
    const float x = s * rsqrtf(rss[t] * (1.f / DM) + EPS) + bfv[hd];
    const float ls = fminf(x, 0.f) - log1pf(__expf(-fabsf(x)));
    const int b = t / SEQ, sq = t % SEQ; LF[((size_t)(b * NH + hd)) * SEQ + sq] = ls;
}
__global__ void __launch_bounds__(256) k_scan(const float* __restrict__ LF, float* __restrict__ CS) {
    __shared__ float part[256];
    const int bh = blockIdx.x, tid = threadIdx.x; const float* src = LF + (size_t)bh * SEQ + tid * 8; float v[8]; float s = 0.f;
#pragma unroll
    for (int i = 0; i < 8; ++i) { s += src[i]; v[i] = s; }
    part[tid] = s; __syncthreads();
    if (tid == 0) { float run = 0.f; for (int i = 0; i < 256; ++i) { const float x = part[i]; part[i] = run; run += x; } }
    __syncthreads();
    const float base = part[tid]; float* dst = CS + (size_t)bh * SEQ + tid * 8;
#pragma unroll
    for (int i = 0; i < 8; ++i) dst[i] = -(base + v[i]) * LOG2E;
}

__global__ void __launch_bounds__(256) k_attn(bf16_t* __restrict__ QZ, const bf16_t* __restrict__ Kb, const bf16_t* __restrict__ Vb, const bf16_t* __restrict__ ZA, const float* __restrict__ CS) {
    __shared__ __attribute__((aligned(16))) bf16_t Ks[32 * 72];
    __shared__ __attribute__((aligned(16))) bf16_t Vt[64 * 40];
    __shared__ float cs[32];
    const int qb = blockIdx.x, h = blockIdx.y, b = blockIdx.z, tid = threadIdx.x, lane = tid & 63, wid = tid >> 6, fr = lane & 15, g = lane >> 4;
    const int q0 = qb * 64 + wid * 16, q = q0 + fr; const size_t rowbase = (size_t)b * SEQ;
    const bf16_t* qp = QZ + (rowbase + q) * 2048 + h * 64;
    const bf16x8 qf0 = *(const bf16x8*)(qp + g * 8), qf1 = *(const bf16x8*)(qp + 32 + g * 8);
    f32x4 o[4]; for (int i = 0; i < 4; ++i) o[i] = (f32x4){0.f, 0.f, 0.f, 0.f};
    float m = -INFINITY, l = 0.f;
    const int ntiles = (qb * 64 + 64) / 32;
    for (int kt = 0; kt < ntiles; ++kt) {
        const int kv0 = kt * 32;
        __syncthreads();
        { const int r = tid >> 3, ch = tid & 7;
          const u32x4 kk = *(const u32x4*)(Kb + (rowbase + kv0 + r) * DM + h * 64 + ch * 8); *(u32x4*)(Ks + r * 72 + ch * 8) = kk;
          const u32x4 vv = *(const u32x4*)(Vb + (rowbase + kv0 + r) * DM + h * 64 + ch * 8);
          Vt[(ch * 8 + 0) * 40 + r] = (bf16_t)(vv.x & 0xffff); Vt[(ch * 8 + 1) * 40 + r] = (bf16_t)(vv.x >> 16);
          Vt[(ch * 8 + 2) * 40 + r] = (bf16_t)(vv.y & 0xffff); Vt[(ch * 8 + 3) * 40 + r] = (bf16_t)(vv.y >> 16);
          Vt[(ch * 8 + 4) * 40 + r] = (bf16_t)(vv.z & 0xffff); Vt[(ch * 8 + 5) * 40 + r] = (bf16_t)(vv.z >> 16);
          Vt[(ch * 8 + 6) * 40 + r] = (bf16_t)(vv.w & 0xffff); Vt[(ch * 8 + 7) * 40 + r] = (bf16_t)(vv.w >> 16); }
        if (tid < 32) cs[tid] = CS[((size_t)(b * NH + h)) * SEQ + kv0 + tid];
        __syncthreads();
        if (kv0 <= q0 + 15) {
            f32x4 s0 = (f32x4){0.f, 0.f, 0.f, 0.f}, s1 = s0;
            const bf16x8 k00 = *(const bf16x8*)(Ks + fr * 72 + g * 8), k01 = *(const bf16x8*)(Ks + fr * 72 + 32 + g * 8);
            const bf16x8 k10 = *(const bf16x8*)(Ks + (fr + 16) * 72 + g * 8), k11 = *(const bf16x8*)(Ks + (fr + 16) * 72 + 32 + g * 8);
            s0 = __builtin_amdgcn_mfma_f32_16x16x32_bf16(k00, qf0, s0, 0, 0, 0); s0 = __builtin_amdgcn_mfma_f32_16x16x32_bf16(k01, qf1, s0, 0, 0, 0);
            s1 = __builtin_amdgcn_mfma_f32_16x16x32_bf16(k10, qf0, s1, 0, 0, 0); s1 = __builtin_amdgcn_mfma_f32_16x16x32_bf16(k11, qf1, s1, 0, 0, 0);
            float p0[4], p1[4]; float mx = -INFINITY;
#pragma unroll
            for (int r = 0; r < 4; ++r) { const int ka = 4 * g + r, kb2 = 16 + 4 * g + r;
                p0[r] = (kv0 + ka > q) ? -INFINITY : s0[r] + cs[ka]; p1[r] = (kv0 + kb2 > q) ? -INFINITY : s1[r] + cs[kb2];
                mx = fmaxf(mx, fmaxf(p0[r], p1[r])); }
            mx = fmaxf(mx, __shfl_xor(mx, 16)); mx = fmaxf(mx, __shfl_xor(mx, 32));
            const float mn = fmaxf(m, mx), alpha = exp2f(m - mn); float ps = 0.f;
#pragma unroll
            for (int r = 0; r < 4; ++r) { p0[r] = exp2f(p0[r] - mn); p1[r] = exp2f(p1[r] - mn); ps += p0[r] + p1[r]; }
            l = l * alpha + ps; m = mn;
            u32x4 pw; pw.x = pk2(p0[0], p0[1]); pw.y = pk2(p0[2], p0[3]); pw.z = pk2(p1[0], p1[1]); pw.w = pk2(p1[2], p1[3]);
            const bf16x8 pf = __builtin_bit_cast(bf16x8, pw);
#pragma unroll
            for (int di = 0; di < 4; ++di) { o[di] = o[di] * alpha;
                const u32x2 lo = *(const u32x2*)(Vt + (16 * di + fr) * 40 + 4 * g), hi = *(const u32x2*)(Vt + (16 * di + fr) * 40 + 16 + 4 * g);
                u32x4 vw; vw.x = lo.x; vw.y = lo.y; vw.z = hi.x; vw.w = hi.y;
                o[di] = __builtin_amdgcn_mfma_f32_16x16x32_bf16(__builtin_bit_cast(bf16x8, vw), pf, o[di], 0, 0, 0); }
        }
    }
    l += __shfl_xor(l, 16); l += __shfl_xor(l, 32);
    const float inv = 1.f / l;
#pragma unroll
    for (int di = 0; di < 4; ++di) { const int d = 16 * di + 4 * g; const u32x2 zw = *(const u32x2*)(ZA + (rowbase + q) * DM + h * 64 + d);
        f32x4 r; r.x = o[di].x * inv * bflo(zw.x); r.y = o[di].y * inv * bfhi(zw.x); r.z = o[di].z * inv * bflo(zw.y); r.w = o[di].w * inv * bfhi(zw.y);
        st_bf16x4(QZ + (rowbase + q) * 2048 + h * 64 + d, r); }
}

__global__ void __launch_bounds__(256) k_pool(const bf16_t* __restrict__ Y, bf16_t* __restrict__ QZ) {
    const size_t i = blockIdx.x * (size_t)256 + threadIdx.x; const int t = (int)(i >> 7), c = (int)(i & 127) * 8;
    const int s = t % SEQ, w = 2 << (c >> 8), cnt = (s + 1 < w) ? s + 1 : w;
    float acc[8] = {}; float y0[8];
    for (int j = 0; j < cnt; ++j) { const u32x4 v = *(const u32x4*)(Y + (size_t)(t - j) * DM + c);
        const float f[8] = {bflo(v.x), bfhi(v.x), bflo(v.y), bfhi(v.y), bflo(v.z), bfhi(v.z), bflo(v.w), bfhi(v.w)};
#pragma unroll
        for (int e = 0; e < 8; ++e) { acc[e] += f[e]; if (j == 0) y0[e] = f[e]; } }
    const float ic = 1.f / (float)cnt;
    bf16_t* zp = QZ + (size_t)t * 2048 + 1024 + c; const u32x4 z = *(const u32x4*)zp;
    const float zf[8] = {bflo(z.x), bfhi(z.x), bflo(z.y), bfhi(z.y), bflo(z.z), bfhi(z.z), bflo(z.w), bfhi(z.w)};
    float r[8];
#pragma unroll
    for (int e = 0; e < 8; ++e) r[e] = (acc[e] * ic - y0[e]) * zf[e];
    u32x4 o; o.x = pk2(r[0], r[1]); o.y = pk2(r[2], r[3]); o.z = pk2(r[4], r[5]); o.w = pk2(r[6], r[7]); *(u32x4*)zp = o;
}

__global__ void __launch_bounds__(256) k_rmspost(const float* __restrict__ mix, const float* base, const float* __restrict__ gp, float* out, bf16_t* __restrict__ hb) {
    const int lane = threadIdx.x & 63; const int gw = blockIdx.x * 4 + (threadIdx.x >> 6), ngw = gridDim.x * 4;
    for (int m = gw; m < T; m += ngw) {
        const f32x4* xr = (const f32x4*)(mix + (size_t)m * DM) + lane; float s = 0.f; f32x4 v[4];
#pragma unroll
        for (int j = 0; j < 4; ++j) { v[j] = xr[64 * j]; s += (v[j].x * v[j].x + v[j].y * v[j].y) + (v[j].z * v[j].z + v[j].w * v[j].w); }
        const float rstd = rsqrtf(wave_sum(s) * (1.f / DM) + EPS);
#pragma unroll
        for (int j = 0; j < 4; ++j) { const f32x4 bs = ((const f32x4*)(base + (size_t)m * DM) + lane)[64 * j]; const f32x4 gg = ((const f32x4*)gp + lane)[64 * j];
            const f32x4 r = bs + v[j] * rstd * gg; ((f32x4*)(out + (size_t)m * DM) + lane)[64 * j] = r;
            u32x2 w; w.x = pk2(r.x, r.y); w.y = pk2(r.z, r.w); ((u32x2*)(hb + (size_t)m * DM) + lane)[64 * j] = w; }
    }
}

extern "C" void kernel_launch(void* const* d_in, const int* in_sizes, int n_in, void* d_out, int out_size, void* d_ws, size_t ws_size, hipStream_t stream) {
    if (n_in != 11 || in_sizes[0] != T * DM || out_size != T * DM || ws_size < WS_END) { fprintf(stderr, "kernel_launch: unexpected shapes (n_in %d, in0 %d, out %d, ws %zu)\n", n_in, n_in > 0 ? in_sizes[0] : -1, out_size, ws_size); return; }
    const float* x = (const float*)d_in[0]; const float* p = (const float*)d_in[1]; const float* norm_pre = (const float*)d_in[2]; const float* norm_post = (const float*)d_in[3];
    const float* w_in = (const float*)d_in[4]; const float* b_f = (const float*)d_in[5]; const float* w_pool = (const float*)d_in[6]; const float* pool_scale = (const float*)d_in[7];
    const float* w_out = (const float*)d_in[8]; const float* w_pg = (const float*)d_in[9]; const float* w_pe = (const float*)d_in[10];
    float* out = (float*)d_out; unsigned char* ws = (unsigned char*)d_ws;
    float* LF = (float*)(ws + WS_LF); float* CS = (float*)(ws + WS_CS); float* RSS = (float*)(ws + WS_RSS);
    bf16_t* WIN = (bf16_t*)(ws + WS_WIN); bf16_t* WF = (bf16_t*)(ws + WS_WF); bf16_t* WOUT = (bf16_t*)(ws + WS_WOUT); bf16_t* WPG = (bf16_t*)(ws + WS_WPG); bf16_t* WPE = (bf16_t*)(ws + WS_WPE);
    bf16_t* HB = (bf16_t*)(ws + WS_HB); bf16_t* QZ = (bf16_t*)(ws + WS_QZ); bf16_t* KB = (bf16_t*)(ws + WS_K); bf16_t* VB = (bf16_t*)(ws + WS_V); bf16_t* ZA = (bf16_t*)(ws + WS_ZA); bf16_t* YB = (bf16_t*)(ws + WS_Y);
    float* MIX = (float*)(ws + WS_MIX); bf16_t* H1B = ZA; bf16_t* PE = YB; bf16_t* PB = HB;
    for (int l = 0; l < DEPTH; ++l) {
        const float* wi = w_in + (size_t)l * DM * INC; const float* gpre = norm_pre + l * DM; bf16_t* wt = WIN + (size_t)l * NIN * DM;
        k_transpose<<<1024, 256, 0, stream>>>(wi, DM, 4096, INC, 0, gpre, wt);
        k_transpose<<<512, 256, 0, stream>>>(wi, DM, 1024, INC, 5136, gpre, wt + (size_t)5120 * DM);
        k_poolfold<<<dim3(4, 16, 4), 256, 0, stream>>>(wi, w_pool + (size_t)l * 4 * 256 * 256, gpre, wt);
        k_fcols<<<64, 256, 0, stream>>>(wi, gpre, WF + (size_t)l * 16 * DM);
        k_transpose<<<512, 256, 0, stream>>>(w_out + (size_t)l * MIXW * DM, MIXW, DM, DM, 0, nullptr, WOUT + (size_t)l * DM * MIXW);
        k_transpose<<<512, 256, 0, stream>>>(w_pg + (size_t)l * DM * DM, DM, DM, DM, 0, nullptr, WPG + (size_t)l * DM * DM);
        k_transpose<<<128, 256, 0, stream>>>(w_pe + (size_t)l * PLE * DM, PLE, DM, DM, 0, nullptr, WPE + (size_t)l * DM * PLE);
    }
    k_rows_bf16<<<2048, 256, 0, stream>>>(x, HB, RSS, T);
    for (int l = 0; l < DEPTH; ++l) {
        const float* rss = RSS + (size_t)l * T;
        EpiIn ein{rss, QZ, KB, VB, ZA, YB, pool_scale + l * 1024};
        k_gemm<EpiIn><<<dim3(NIN / 128, T / 128), 256, 0, stream>>>(HB, DM, WIN + (size_t)l * NIN * DM, DM, DM, ein);
        k_flogit<<<T / 16, 256, 0, stream>>>(HB, WF + (size_t)l * 16 * DM, rss, b_f + l * NH, LF);
        k_scan<<<BATCH * NH, 256, 0, stream>>>(LF, CS);
        k_attn<<<dim3(SEQ / 64, NH, BATCH), 256, 0, stream>>>(QZ, KB, VB, ZA, CS);
        k_pool<<<T * 128 / 256, 256, 0, stream>>>(YB, QZ);
        EpiF32 emix{MIX, DM};
        k_gemm<EpiF32><<<dim3(DM / 128, T / 128), 256, 0, stream>>>(QZ, 2048, WOUT + (size_t)l * DM * MIXW, MIXW, MIXW, emix);
        k_rmspost<<<2048, 256, 0, stream>>>(MIX, l == 0 ? x : out, norm_post + l * DM, out, H1B);
        k_cvt<<<2048, 256, 0, stream>>>(p + (size_t)l * T * PLE, PB, (size_t)T * PLE / 4);
        EpiBf epe{PE, DM};
        k_gemm<EpiBf><<<dim3(DM / 128, T / 128), 256, 0, stream>>>(PB, PLE, WPE + (size_t)l * DM * PLE, PLE, PLE, epe);
        EpiGate eg{out, PE, HB};
        k_gemm<EpiGate><<<dim3(DM / 128, T / 128), 256, 0, stream>>>(H1B, DM, WPG + (size_t)l * DM * DM, DM, DM, eg);
        if (l + 1 < DEPTH) k_rows_bf16<<<2048, 256, 0, stream>>>(out, nullptr, RSS + (size_t)(l + 1) * T, T);
    }
}
```

```cpp
#include <hip/hip_runtime.h>
#include <hip/hip_bf16.h>
#include <cstdio>
#include <cstdint>
#include <cmath>

typedef unsigned short bf16_t;
typedef short bf16x8 __attribute__((ext_vector_type(8)));
typedef float f32x4 __attribute__((ext_vector_type(4)));
typedef unsigned u32x4 __attribute__((ext_vector_type(4)));
typedef unsigned u32x2 __attribute__((ext_vector_type(2)));

constexpr int DM = 1024, BATCH = 16, SEQ = 2048, T = BATCH * SEQ, NH = 16, HD = 64, PLE = 256, DEPTH = 2;
constexpr int INC = 6160;
constexpr int NIN = 6144;
constexpr int MIXW = 2048;
constexpr float EPS = 1e-6f;
constexpr float LOG2E = 1.4426950408889634f;
constexpr float C2 = 0.125f * LOG2E;

constexpr size_t MiB = 1u << 20;
constexpr size_t WS_CTL = 0, CTL_ZERO_BYTES = 1 * MiB;
constexpr size_t WS_LF = 1 * MiB;
constexpr size_t WS_CS = 3 * MiB;
constexpr size_t WS_RSS = 5 * MiB;
constexpr size_t WS_WIN = 8 * MiB;
constexpr size_t WS_WF = 32 * MiB;
constexpr size_t WS_WOUT = 33 * MiB;
constexpr size_t WS_WPG = 41 * MiB;
constexpr size_t WS_WPE = 45 * MiB;
constexpr size_t WS_HB = 48 * MiB;
constexpr size_t WS_QZ = 112 * MiB;
constexpr size_t WS_K = 240 * MiB;
constexpr size_t WS_V = 304 * MiB;
constexpr size_t WS_ZA = 368 * MiB;
constexpr size_t WS_Y = 432 * MiB;
constexpr size_t WS_END = 496 * MiB;
constexpr size_t WS_MIX = WS_K;

__device__ __forceinline__ unsigned f2bf(float f) { unsigned u = __builtin_bit_cast(unsigned, f); return (u + 0x7fffu + ((u >> 16) & 1u)) >> 16; }
__device__ __forceinline__ unsigned pk2(float lo, float hi) { return f2bf(lo) | (f2bf(hi) << 16); }
__device__ __forceinline__ float bf2f(unsigned short h) { return __builtin_bit_cast(float, (unsigned)h << 16); }
__device__ __forceinline__ float bflo(unsigned w) { return __builtin_bit_cast(float, w << 16); }
__device__ __forceinline__ float bfhi(unsigned w) { return __builtin_bit_cast(float, w & 0xffff0000u); }
__device__ __forceinline__ float silu_f(float x) { return x / (1.f + __expf(-x)); }
__device__ __forceinline__ float sigmoid_f(float x) { return 1.f / (1.f + __expf(-x)); }
__device__ __forceinline__ float wave_sum(float v) {
#pragma unroll
    for (int o = 1; o < 64; o <<= 1) v += __shfl_xor(v, o);
    return v;
}
__device__ __forceinline__ void st_bf16x4(bf16_t* p, f32x4 v) { u32x2 w; w.x = pk2(v.x, v.y); w.y = pk2(v.z, v.w); *(u32x2*)p = w; }
#ifndef MK_CODE
#define MK_CODE 63
#endif
#ifndef MK_MASK
#define MK_MASK 0x7FF
#endif
#if MK_MASK != 0x7FF
__global__ void __launch_bounds__(256) k_transpose(const float* __restrict__ W, int K, int N, int ldn, int n0, const float* __restrict__ gk, bf16_t* __restrict__ dst) {
    __shared__ float scr_all[4][64 * 33];
    const int lane = threadIdx.x & 63, wid = threadIdx.x >> 6;
    float* scr = scr_all[wid];
    const int nblk = N / 32, nitems = (K / 64) * nblk;
    for (int item = blockIdx.x * 4 + wid; item < nitems; item += gridDim.x * 4) {
        const int kb = item / nblk, nb = item % nblk, k0 = 64 * kb, nn0 = 32 * nb;
        for (int i = 0; i < 32; ++i) { const int kk = 2 * i + (lane >> 5); float v = W[(size_t)(k0 + kk) * ldn + n0 + nn0 + (lane & 31)]; if (gk) v *= gk[k0 + kk]; scr[kk * 33 + (lane & 31)] = v; }
        __builtin_amdgcn_s_waitcnt(0xc07f); __builtin_amdgcn_wave_barrier();
        const int c = lane & 7;
        for (int j = 0; j < 4; ++j) { const int n = (lane >> 3) + 8 * j; const float* s = scr + (8 * c) * 33 + n;
            u32x4 o; o.x = pk2(s[0 * 33], s[1 * 33]); o.y = pk2(s[2 * 33], s[3 * 33]); o.z = pk2(s[4 * 33], s[5 * 33]); o.w = pk2(s[6 * 33], s[7 * 33]);
            *(u32x4*)(dst + (size_t)(nn0 + n) * K + k0 + 8 * c) = o; }
        __builtin_amdgcn_s_waitcnt(0xc07f); __builtin_amdgcn_wave_barrier();
    }
}
__global__ void k_fcols(const float* __restrict__ W, const float* __restrict__ gk, bf16_t* __restrict__ dst) {
    const int i = blockIdx.x * blockDim.x + threadIdx.x; if (i >= 16 * DM) return;
    const int n = i / DM, k = i % DM; dst[i] = (bf16_t)f2bf(gk[k] * W[(size_t)k * INC + 4096 + n]);
}
__global__ void __launch_bounds__(256) k_poolfold(const float* __restrict__ W, const float* __restrict__ P, const float* __restrict__ gk, bf16_t* __restrict__ dst) {
    __shared__ float As[16][65], Bs[16][64];
    const int g = blockIdx.z, k0 = blockIdx.y * 64, n0 = blockIdx.x * 64, tid = threadIdx.x, tx = tid & 15, ty = tid >> 4;
    float acc[4][4] = {};
    for (int j0 = 0; j0 < 256; j0 += 16) {
        for (int i = tid; i < 64 * 16; i += 256) { const int kk = i >> 4, jj = i & 15; As[jj][kk] = W[(size_t)(k0 + kk) * INC + 4112 + 256 * g + j0 + jj]; }
        for (int i = tid; i < 16 * 64; i += 256) { const int jj = i >> 6, nn = i & 63; Bs[jj][nn] = P[((size_t)g * 256 + j0 + jj) * 256 + n0 + nn]; }
        __syncthreads();
#pragma unroll
        for (int jj = 0; jj < 16; ++jj) { float a[4], b[4];
#pragma unroll
            for (int i = 0; i < 4; ++i) { a[i] = As[jj][ty * 4 + i]; b[i] = Bs[jj][tx * 4 + i]; }
#pragma unroll
            for (int i = 0; i < 4; ++i)
#pragma unroll
                for (int q = 0; q < 4; ++q) acc[i][q] += a[i] * b[q]; }
        __syncthreads();
    }
    float gs[4];
#pragma unroll
    for (int i = 0; i < 4; ++i) gs[i] = gk[k0 + ty * 4 + i];
#pragma unroll
    for (int q = 0; q < 4; ++q) { u32x2 o; o.x = pk2(acc[0][q] * gs[0], acc[1][q] * gs[1]); o.y = pk2(acc[2][q] * gs[2], acc[3][q] * gs[3]);
        *(u32x2*)(dst + (size_t)(4096 + 256 * g + n0 + tx * 4 + q) * DM + k0 + ty * 4) = o; }
}
__global__ void __launch_bounds__(256) k_rows_bf16(const float* __restrict__ x, bf16_t* __restrict__ xb, float* __restrict__ rss, int rows) {
    const int lane = threadIdx.x & 63; const int gw = blockIdx.x * 4 + (threadIdx.x >> 6), ngw = gridDim.x * 4;
    for (int m = gw; m < rows; m += ngw) {
        const f32x4* xr = (const f32x4*)(x + (size_t)m * DM) + lane; float s = 0.f; f32x4 v[4];
#pragma unroll
        for (int j = 0; j < 4; ++j) { v[j] = xr[64 * j]; s += (v[j].x * v[j].x + v[j].y * v[j].y) + (v[j].z * v[j].z + v[j].w * v[j].w); }
        s = wave_sum(s);
        if (xb) { u32x2* o = (u32x2*)(xb + (size_t)m * DM) + lane;
#pragma unroll
            for (int j = 0; j < 4; ++j) { u32x2 w; w.x = pk2(v[j].x, v[j].y); w.y = pk2(v[j].z, v[j].w); o[64 * j] = w; } }
        if (lane == 0) rss[m] = s;
    }
}
__global__ void k_cvt(const float* __restrict__ src, bf16_t* __restrict__ dst, size_t n4) {
    for (size_t i = blockIdx.x * (size_t)blockDim.x + threadIdx.x; i < n4; i += (size_t)gridDim.x * blockDim.x) { const f32x4 v = ((const f32x4*)src)[i]; u32x2 w; w.x = pk2(v.x, v.y); w.y = pk2(v.z, v.w); ((u32x2*)dst)[i] = w; }
}

template <class Epi>
__global__ void __launch_bounds__(256) k_gemm(const bf16_t* __restrict__ A, int lda, const bf16_t* __restrict__ Bt, int ldb, int K, Epi epi) {
    __shared__ __attribute__((aligned(16))) bf16_t As[128 * 40];
    __shared__ __attribute__((aligned(16))) bf16_t Bs[128 * 40];
    const int tid = threadIdx.x, lane = tid & 63, wid = tid >> 6, wr = wid >> 1, wc = wid & 1, fr = lane & 15, fq = lane >> 4;
    const int m0 = blockIdx.y * 128, n0 = blockIdx.x * 128;
    f32x4 acc[4][4];
#pragma unroll
    for (int i = 0; i < 4; ++i)
#pragma unroll
        for (int j = 0; j < 4; ++j) acc[i][j] = (f32x4){0.f, 0.f, 0.f, 0.f};
    for (int k0 = 0; k0 < K; k0 += 32) {
#pragma unroll
        for (int i = 0; i < 2; ++i) { const int row = (tid >> 2) + 64 * i, kc = tid & 3;
            const u32x4 a = *(const u32x4*)(A + (size_t)(m0 + row) * lda + k0 + kc * 8);
            const u32x4 b = *(const u32x4*)(Bt + (size_t)(n0 + row) * ldb + k0 + kc * 8);
            *(u32x4*)(As + row * 40 + kc * 8) = a; *(u32x4*)(Bs + row * 40 + kc * 8) = b; }
        __syncthreads();
        bf16x8 af[4], bfr[4];
#pragma unroll
        for (int i = 0; i < 4; ++i) { af[i] = *(const bf16x8*)(As + (wr * 64 + i * 16 + fr) * 40 + fq * 8); bfr[i] = *(const bf16x8*)(Bs + (wc * 64 + i * 16 + fr) * 40 + fq * 8); }
#pragma unroll
        for (int i = 0; i < 4; ++i)
#pragma unroll
            for (int j = 0; j < 4; ++j) acc[i][j] = __builtin_amdgcn_mfma_f32_16x16x32_bf16(bfr[j], af[i], acc[i][j], 0, 0, 0);
        __syncthreads();
    }
#pragma unroll
    for (int i = 0; i < 4; ++i)
#pragma unroll
        for (int j = 0; j < 4; ++j) epi(m0 + wr * 64 + i * 16 + fr, n0 + wc * 64 + j * 16 + 4 * fq, acc[i][j]);
}


struct V1EpiIn {
    const float* rss; bf16_t *QZ, *Kb, *Vb, *ZA, *Y; const float* pscale;
    __device__ __forceinline__ void operator()(int row, int col, f32x4 v) const {
        const float rstd = rsqrtf(rss[row] * (1.f / DM) + EPS);
        const int seg = col >> 10, c = col & 1023;
        v = v * rstd;
        if (seg == 0) { v = v * C2; st_bf16x4(QZ + (size_t)row * 2048 + c, v); }
        else if (seg == 1) st_bf16x4(Kb + (size_t)row * DM + c, v);
        else if (seg == 2) st_bf16x4(Vb + (size_t)row * DM + c, v);
        else if (seg == 3) { v.x = silu_f(v.x); v.y = silu_f(v.y); v.z = silu_f(v.z); v.w = silu_f(v.w); st_bf16x4(ZA + (size_t)row * DM + c, v); }
        else if (seg == 4) st_bf16x4(Y + (size_t)row * DM + c, v);
        else { const f32x4 ps = *(const f32x4*)(pscale + c); v.x = silu_f(v.x) * ps.x; v.y = silu_f(v.y) * ps.y; v.z = silu_f(v.z) * ps.z; v.w = silu_f(v.w) * ps.w; st_bf16x4(QZ + (size_t)row * 2048 + 1024 + c, v); }
    }
};
struct V1EpiF32 { float* O; int ldc; __device__ __forceinline__ void operator()(int row, int col, f32x4 v) const { *(f32x4*)(O + (size_t)row * ldc + col) = v; } };
struct V1EpiBf { bf16_t* O; int ldc; __device__ __forceinline__ void operator()(int row, int col, f32x4 v) const { st_bf16x4(O + (size_t)row * ldc + col, v); } };
struct V1EpiGate {
    float* out; const bf16_t* PE; bf16_t* HB;
    __device__ __forceinline__ void operator()(int row, int col, f32x4 v) const {
        const size_t off = (size_t)row * DM + col; const f32x4 h1 = *(const f32x4*)(out + off); const u32x2 pw = *(const u32x2*)(PE + off);
        f32x4 h2; h2.x = h1.x + sigmoid_f(v.x) * bflo(pw.x); h2.y = h1.y + sigmoid_f(v.y) * bfhi(pw.x); h2.z = h1.z + sigmoid_f(v.z) * bflo(pw.y); h2.w = h1.w + sigmoid_f(v.w) * bfhi(pw.y);
        *(f32x4*)(out + off) = h2; st_bf16x4(HB + off, h2);
    }
};

__global__ void __launch_bounds__(256) k_flogit(const bf16_t* __restrict__ HB, const bf16_t* __restrict__ WF, const float* __restrict__ rss, const float* __restrict__ bfv, float* __restrict__ LF) {
    const int r = threadIdx.x >> 4, hd = threadIdx.x & 15, t = blockIdx.x * 16 + r;
    const u32x4* a = (const u32x4*)(HB + (size_t)t * DM); const u32x4* w = (const u32x4*)(WF + (size_t)hd * DM);
    float s = 0.f;
    for (int i = 0; i < DM / 8; ++i) { const u32x4 av = a[i], wv = w[i];
        s += bflo(av.x) * bflo(wv.x) + bfhi(av.x) * bfhi(wv.x) + bflo(av.y) * bflo(wv.y) + bfhi(av.y) * bfhi(wv.y) + bflo(av.z) * bflo(wv.z) + bfhi(av.z) * bfhi(wv.z) + bflo(av.w) * bflo(wv.w) + bfhi(av.w) * bfhi(wv.w); }
    const float x = s * rsqrtf(rss[t] * (1.f / DM) + EPS) + bfv[hd];
    const float ls = fminf(x, 0.f) - log1pf(__expf(-fabsf(x)));
    const int b = t / SEQ, sq = t % SEQ; LF[((size_t)(b * NH + hd)) * SEQ + sq] = ls;
}
__global__ void __launch_bounds__(256) k_scan(const float* __restrict__ LF, float* __restrict__ CS) {
    __shared__ float part[256];
    const int bh = blockIdx.x, tid = threadIdx.x; const float* src = LF + (size_t)bh * SEQ + tid * 8; float v[8]; float s = 0.f;
#pragma unroll
    for (int i = 0; i < 8; ++i) { s += src[i]; v[i] = s; }
    part[tid] = s; __syncthreads();
    if (tid == 0) { float run = 0.f; for (int i = 0; i < 256; ++i) { const float x = part[i]; part[i] = run; run += x; } }
    __syncthreads();
    const float base = part[tid]; float* dst = CS + (size_t)bh * SEQ + tid * 8;
#pragma unroll
    for (int i = 0; i < 8; ++i) dst[i] = -(base + v[i]) * LOG2E;
}

__global__ void __launch_bounds__(256) k_attn(bf16_t* __restrict__ QZ, const bf16_t* __restrict__ Kb, const bf16_t* __restrict__ Vb, const bf16_t* __restrict__ ZA, const float* __restrict__ CS) {
    __shared__ __attribute__((aligned(16))) bf16_t Ks[32 * 72];
    __shared__ __attribute__((aligned(16))) bf16_t Vt[64 * 40];
    __shared__ float cs[32];
    const int qb = blockIdx.x, h = blockIdx.y, b = blockIdx.z, tid = threadIdx.x, lane = tid & 63, wid = tid >> 6, fr = lane & 15, g = lane >> 4;
    const int q0 = qb * 64 + wid * 16, q = q0 + fr; const size_t rowbase = (size_t)b * SEQ;
    const bf16_t* qp = QZ + (rowbase + q) * 2048 + h * 64;
    const bf16x8 qf0 = *(const bf16x8*)(qp + g * 8), qf1 = *(const bf16x8*)(qp + 32 + g * 8);
    f32x4 o[4]; for (int i = 0; i < 4; ++i) o[i] = (f32x4){0.f, 0.f, 0.f, 0.f};
    float m = -INFINITY, l = 0.f;
    const int ntiles = (qb * 64 + 64) / 32;
    for (int kt = 0; kt < ntiles; ++kt) {
        const int kv0 = kt * 32;
        __syncthreads();
        { const int r = tid >> 3, ch = tid & 7;
          const u32x4 kk = *(const u32x4*)(Kb + (rowbase + kv0 + r) * DM + h * 64 + ch * 8); *(u32x4*)(Ks + r * 72 + ch * 8) = kk;
          const u32x4 vv = *(const u32x4*)(Vb + (rowbase + kv0 + r) * DM + h * 64 + ch * 8);
          Vt[(ch * 8 + 0) * 40 + r] = (bf16_t)(vv.x & 0xffff); Vt[(ch * 8 + 1) * 40 + r] = (bf16_t)(vv.x >> 16);
          Vt[(ch * 8 + 2) * 40 + r] = (bf16_t)(vv.y & 0xffff); Vt[(ch * 8 + 3) * 40 + r] = (bf16_t)(vv.y >> 16);
          Vt[(ch * 8 + 4) * 40 + r] = (bf16_t)(vv.z & 0xffff); Vt[(ch * 8 + 5) * 40 + r] = (bf16_t)(vv.z >> 16);
          Vt[(ch * 8 + 6) * 40 + r] = (bf16_t)(vv.w & 0xffff); Vt[(ch * 8 + 7) * 40 + r] = (bf16_t)(vv.w >> 16); }
        if (tid < 32) cs[tid] = CS[((size_t)(b * NH + h)) * SEQ + kv0 + tid];
        __syncthreads();
        if (kv0 <= q0 + 15) {
            f32x4 s0 = (f32x4){0.f, 0.f, 0.f, 0.f}, s1 = s0;
            const bf16x8 k00 = *(const bf16x8*)(Ks + fr * 72 + g * 8), k01 = *(const bf16x8*)(Ks + fr * 72 + 32 + g * 8);
            const bf16x8 k10 = *(const bf16x8*)(Ks + (fr + 16) * 72 + g * 8), k11 = *(const bf16x8*)(Ks + (fr + 16) * 72 + 32 + g * 8);
            s0 = __builtin_amdgcn_mfma_f32_16x16x32_bf16(k00, qf0, s0, 0, 0, 0); s0 = __builtin_amdgcn_mfma_f32_16x16x32_bf16(k01, qf1, s0, 0, 0, 0);
            s1 = __builtin_amdgcn_mfma_f32_16x16x32_bf16(k10, qf0, s1, 0, 0, 0); s1 = __builtin_amdgcn_mfma_f32_16x16x32_bf16(k11, qf1, s1, 0, 0, 0);
            float p0[4], p1[4]; float mx = -INFINITY;
#pragma unroll
            for (int r = 0; r < 4; ++r) { const int ka = 4 * g + r, kb2 = 16 + 4 * g + r;
                p0[r] = (kv0 + ka > q) ? -INFINITY : s0[r] + cs[ka]; p1[r] = (kv0 + kb2 > q) ? -INFINITY : s1[r] + cs[kb2];
                mx = fmaxf(mx, fmaxf(p0[r], p1[r])); }
            mx = fmaxf(mx, __shfl_xor(mx, 16)); mx = fmaxf(mx, __shfl_xor(mx, 32));
            const float mn = fmaxf(m, mx), alpha = exp2f(m - mn); float ps = 0.f;
#pragma unroll
            for (int r = 0; r < 4; ++r) { p0[r] = exp2f(p0[r] - mn); p1[r] = exp2f(p1[r] - mn); ps += p0[r] + p1[r]; }
            l = l * alpha + ps; m = mn;
            u32x4 pw; pw.x = pk2(p0[0], p0[1]); pw.y = pk2(p0[2], p0[3]); pw.z = pk2(p1[0], p1[1]); pw.w = pk2(p1[2], p1[3]);
            const bf16x8 pf = __builtin_bit_cast(bf16x8, pw);
#pragma unroll
            for (int di = 0; di < 4; ++di) { o[di] = o[di] * alpha;
                const u32x2 lo = *(const u32x2*)(Vt + (16 * di + fr) * 40 + 4 * g), hi = *(const u32x2*)(Vt + (16 * di + fr) * 40 + 16 + 4 * g);
                u32x4 vw; vw.x = lo.x; vw.y = lo.y; vw.z = hi.x; vw.w = hi.y;
                o[di] = __builtin_amdgcn_mfma_f32_16x16x32_bf16(__builtin_bit_cast(bf16x8, vw), pf, o[di], 0, 0, 0); }
        }
    }
    l += __shfl_xor(l, 16); l += __shfl_xor(l, 32);
    const float inv = 1.f / l;
#pragma unroll
    for (int di = 0; di < 4; ++di) { const int d = 16 * di + 4 * g; const u32x2 zw = *(const u32x2*)(ZA + (rowbase + q) * DM + h * 64 + d);
        f32x4 r; r.x = o[di].x * inv * bflo(zw.x); r.y = o[di].y * inv * bfhi(zw.x); r.z = o[di].z * inv * bflo(zw.y); r.w = o[di].w * inv * bfhi(zw.y);
        st_bf16x4(QZ + (rowbase + q) * 2048 + h * 64 + d, r); }
}

__global__ void __launch_bounds__(256) k_pool(const bf16_t* __restrict__ Y, bf16_t* __restrict__ QZ) {
    const size_t i = blockIdx.x * (size_t)256 + threadIdx.x; const int t = (int)(i >> 7), c = (int)(i & 127) * 8;
    const int s = t % SEQ, w = 2 << (c >> 8), cnt = (s + 1 < w) ? s + 1 : w;
    float acc[8] = {}; float y0[8];
    for (int j = 0; j < cnt; ++j) { const u32x4 v = *(const u32x4*)(Y + (size_t)(t - j) * DM + c);
        const float f[8] = {bflo(v.x), bfhi(v.x), bflo(v.y), bfhi(v.y), bflo(v.z), bfhi(v.z), bflo(v.w), bfhi(v.w)};
#pragma unroll
        for (int e = 0; e < 8; ++e) { acc[e] += f[e]; if (j == 0) y0[e] = f[e]; } }
    const float ic = 1.f / (float)cnt;
    bf16_t* zp = QZ + (size_t)t * 2048 + 1024 + c; const u32x4 z = *(const u32x4*)zp;
    const float zf[8] = {bflo(z.x), bfhi(z.x), bflo(z.y), bfhi(z.y), bflo(z.z), bfhi(z.z), bflo(z.w), bfhi(z.w)};
    float r[8];
#pragma unroll
    for (int e = 0; e < 8; ++e) r[e] = (acc[e] * ic - y0[e]) * zf[e];
    u32x4 o; o.x = pk2(r[0], r[1]); o.y = pk2(r[2], r[3]); o.z = pk2(r[4], r[5]); o.w = pk2(r[6], r[7]); *(u32x4*)zp = o;
}

__global__ void __launch_bounds__(256) k_rmspost(const float* __restrict__ mix, const float* base, const float* __restrict__ gp, float* out, bf16_t* __restrict__ hb) {
    const int lane = threadIdx.x & 63; const int gw = blockIdx.x * 4 + (threadIdx.x >> 6), ngw = gridDim.x * 4;
    for (int m = gw; m < T; m += ngw) {
        const f32x4* xr = (const f32x4*)(mix + (size_t)m * DM) + lane; float s = 0.f; f32x4 v[4];
#pragma unroll
        for (int j = 0; j < 4; ++j) { v[j] = xr[64 * j]; s += (v[j].x * v[j].x + v[j].y * v[j].y) + (v[j].z * v[j].z + v[j].w * v[j].w); }
        const float rstd = rsqrtf(wave_sum(s) * (1.f / DM) + EPS);
#pragma unroll
        for (int j = 0; j < 4; ++j) { const f32x4 bs = ((const f32x4*)(base + (size_t)m * DM) + lane)[64 * j]; const f32x4 gg = ((const f32x4*)gp + lane)[64 * j];
            const f32x4 r = bs + v[j] * rstd * gg; ((f32x4*)(out + (size_t)m * DM) + lane)[64 * j] = r;
            u32x2 w; w.x = pk2(r.x, r.y); w.y = pk2(r.z, r.w); ((u32x2*)(hb + (size_t)m * DM) + lane)[64 * j] = w; }
    }
}

#endif
namespace pg8 {
#define PG8_LAS __attribute__((address_space(3)))
typedef unsigned short bf16_t;
typedef short bf16x8 __attribute__((ext_vector_type(8)));
typedef float f32x4 __attribute__((ext_vector_type(4)));
typedef unsigned u32x4 __attribute__((ext_vector_type(4)));
constexpr int BM = 256, BK = 64, HALF = 128, HTB = HALF * BK * 2  , STAGE_BYTES = 8 * HTB, NXCD = 8, WGM = 8;

__host__ __device__ __forceinline__ int lds_byte(int r, int c) { const int st = (r >> 4) * 2 + (c >> 5), rr = r & 15, cc = c & 31, ob = rr * 64 + cc * 2; return st * 1024 + (ob ^ (((ob >> 9) & 1) << 5)); }
__host__ __device__ __forceinline__ void stage_rc(int b, int& R, int& C) { const int st = b / 1024, sb = b % 1024, swz = sb ^ (((sb >> 9) & 1) << 5); R = (st >> 1) * 16 + swz / 64; C = (st & 1) * 32 + (swz % 64) / 2; }
__host__ __device__ __forceinline__ int perm32(int rho) { const int n = rho >> 4, i = rho & 15; return 8 * (i >> 2) + 4 * n + (i & 3); }

struct Unit { int pm, pn; };
struct Gemm { const bf16_t* A; const bf16_t* Bt; int M, N, K; };

struct StaticOrder {
    int nM, nN, nwg, G, c;
    __host__ __device__ void init(int M, int N, int G_, int c_) { nM = M / BM; nN = N / BM; nwg = nM * nN; G = G_; c = c_; }
    __host__ __device__ bool next(int i, Unit& u) const {
        const long L = (long)i * G + c; if (L >= nwg) return false;
        int wgid = (int)L; { const int q = nwg / NXCD, r = nwg % NXCD, xcd = wgid % NXCD, off = wgid / NXCD; wgid = (xcd < r ? xcd * (q + 1) : r * (q + 1) + (xcd - r) * q) + off; }
        const int nig = WGM * nN, gid = wgid / nig, fm = gid * WGM, gsz = (nM - fm) < WGM ? (nM - fm) : WGM;
        u.pm = fm + ((wgid % nig) % gsz); u.pn = (wgid % nig) / gsz; return true;
    }
    __device__ __forceinline__ void a_ready(const Unit&) const {}
    __device__ __forceinline__ void done(const Unit&) const {}
};
__device__ __forceinline__ unsigned cvt_pk_bf16(float lo, float hi) { unsigned r; asm volatile("v_cvt_pk_bf16_f32 %0, %1, %2" : "=v"(r) : "v"(lo), "v"(hi)); return r; }
typedef float f32x2 __attribute__((ext_vector_type(2)));
struct EpiF32 {
    static constexpr bool PERM = false, AFTER_DRAIN = false;
    float* C; int ldc;
    __device__ __forceinline__ void operator()(const f32x4 (&acc)[2][2][4][2], const Unit& u, int wr, int wc, int fr, int fq) const {
        const int row0 = u.pm * BM + wr * 64 + fr, col0 = u.pn * BM + wc * 32 + 4 * fq;
#pragma unroll
        for (int ai = 0; ai < 2; ++ai)
#pragma unroll
            for (int m = 0; m < 4; ++m) { float* rowp = C + (size_t)(row0 + ai * HALF + m * 16) * ldc + col0;
#pragma unroll
                for (int bj = 0; bj < 2; ++bj)
#pragma unroll
                    for (int n = 0; n < 2; ++n) *(f32x4*)(rowp + bj * HALF + n * 16) = acc[ai][bj][m][n]; }
    }
};
struct EpiBf16 {
    static constexpr bool PERM = true, AFTER_DRAIN = false;
    bf16_t* O; int ldc;
    __device__ __forceinline__ void operator()(const f32x4 (&acc)[2][2][4][2], const Unit& u, int wr, int wc, int fr, int fq) const {
        const int row0 = u.pm * BM + wr * 64 + fr, col0 = u.pn * BM + wc * 32 + 8 * fq;
#pragma unroll
        for (int ai = 0; ai < 2; ++ai)
#pragma unroll
            for (int m = 0; m < 4; ++m) { bf16_t* rowp = O + (size_t)(row0 + ai * HALF + m * 16) * ldc + col0;
#pragma unroll
                for (int bj = 0; bj < 2; ++bj) { const f32x4 v0 = acc[ai][bj][m][0], v1 = acc[ai][bj][m][1];
                    u32x4 w; w.x = cvt_pk_bf16(v0[0], v0[1]); w.y = cvt_pk_bf16(v0[2], v0[3]); w.z = cvt_pk_bf16(v1[0], v1[1]); w.w = cvt_pk_bf16(v1[2], v1[3]);
                    *(u32x4*)(rowp + bj * HALF) = w; } }
    }
};
struct EpiIn {
    static constexpr bool PERM = true, AFTER_DRAIN = false;
    const float* rss; bf16_t *QZ, *Kb, *Vb, *ZA, *Y; const float* pscale;
    __device__ __forceinline__ void operator()(const f32x4 (&acc)[2][2][4][2], const Unit& u, int wr, int wc, int fr, int fq) const {
        const int row0 = u.pm * BM + wr * 64 + fr; const int seg = u.pn >> 2, cs0 = (u.pn & 3) * BM + wc * 32 + 8 * fq;
        bf16_t* base; int ldc;
        if (seg == 0) { base = QZ; ldc = 2048; } else if (seg == 1) { base = Kb; ldc = 1024; } else if (seg == 2) { base = Vb; ldc = 1024; }
        else if (seg == 3) { base = ZA; ldc = 1024; } else if (seg == 4) { base = Y; ldc = 1024; } else { base = QZ + 1024; ldc = 2048; }
        f32x4 ps[2][2];
#pragma unroll
        for (int bj = 0; bj < 2; ++bj)
#pragma unroll
            for (int n = 0; n < 2; ++n) ps[bj][n] = (seg == 5) ? *(const f32x4*)(pscale + cs0 + bj * HALF + 4 * n) : (f32x4){1.f, 1.f, 1.f, 1.f};
#pragma unroll
        for (int ai = 0; ai < 2; ++ai)
#pragma unroll
            for (int m = 0; m < 4; ++m) { const int row = row0 + ai * HALF + m * 16;
                float rstd = rsqrtf(rss[row] * (1.f / 1024.f) + 1e-6f); if (seg == 0) rstd *= 0.18033688011112042f;
                bf16_t* rowp = base + (size_t)row * ldc + cs0;
#pragma unroll
                for (int bj = 0; bj < 2; ++bj) { f32x4 v0 = acc[ai][bj][m][0] * rstd, v1 = acc[ai][bj][m][1] * rstd;
                    if (seg == 3 || seg == 5) {
#pragma unroll
                        for (int e = 0; e < 4; ++e) { v0[e] = v0[e] * __builtin_amdgcn_rcpf(1.f + __expf(-v0[e])) * ps[bj][0][e]; v1[e] = v1[e] * __builtin_amdgcn_rcpf(1.f + __expf(-v1[e])) * ps[bj][1][e]; } }
                    u32x4 w; w.x = cvt_pk_bf16(v0[0], v0[1]); w.y = cvt_pk_bf16(v0[2], v0[3]); w.z = cvt_pk_bf16(v1[0], v1[1]); w.w = cvt_pk_bf16(v1[2], v1[3]);
                    *(u32x4*)(rowp + bj * HALF) = w; } }
    }
};
struct EpiGate {
    static constexpr bool PERM = false, AFTER_DRAIN = false;
    float* out; const bf16_t* PE; bf16_t* HB; float* rssn;
    __device__ __forceinline__ void operator()(const f32x4 (&acc)[2][2][4][2], const Unit& u, int wr, int wc, int fr, int fq) const {
        const int row0 = u.pm * BM + wr * 64 + fr, col0 = u.pn * BM + wc * 32 + 4 * fq;
#pragma unroll
        for (int ai = 0; ai < 2; ++ai)
#pragma unroll
            for (int m = 0; m < 4; ++m) { const int row = row0 + ai * HALF + m * 16; const size_t off = (size_t)row * 1024 + col0; float ss = 0.f;
                f32x4 h1[2][2]; u32x2 pw[2][2];
#pragma unroll
                for (int bj = 0; bj < 2; ++bj)
#pragma unroll
                    for (int n = 0; n < 2; ++n) { h1[bj][n] = *(const f32x4*)(out + off + bj * HALF + n * 16); pw[bj][n] = *(const u32x2*)(PE + off + bj * HALF + n * 16); }
#pragma unroll
                for (int bj = 0; bj < 2; ++bj)
#pragma unroll
                    for (int n = 0; n < 2; ++n) { const f32x4 a = acc[ai][bj][m][n]; const u32x2 p = pw[bj][n]; f32x4 h2;
                        h2[0] = h1[bj][n][0] + __builtin_amdgcn_rcpf(1.f + __expf(-a[0])) * __builtin_bit_cast(float, p.x << 16);
                        h2[1] = h1[bj][n][1] + __builtin_amdgcn_rcpf(1.f + __expf(-a[1])) * __builtin_bit_cast(float, p.x & 0xffff0000u);
                        h2[2] = h1[bj][n][2] + __builtin_amdgcn_rcpf(1.f + __expf(-a[2])) * __builtin_bit_cast(float, p.y << 16);
                        h2[3] = h1[bj][n][3] + __builtin_amdgcn_rcpf(1.f + __expf(-a[3])) * __builtin_bit_cast(float, p.y & 0xffff0000u);
                        ss += (h2[0] * h2[0] + h2[1] * h2[1]) + (h2[2] * h2[2] + h2[3] * h2[3]);
                        *(f32x4*)(out + off + bj * HALF + n * 16) = h2;
                        u32x2 w; w.x = cvt_pk_bf16(h2[0], h2[1]); w.y = cvt_pk_bf16(h2[2], h2[3]); *(u32x2*)(HB + off + bj * HALF + n * 16) = w; }
                if (rssn) { ss += __shfl_xor(ss, 16); ss += __shfl_xor(ss, 32); if (fq == 0) atomicAdd(rssn + row, ss); }
                asm volatile("" ::: "memory"); }
    }
};
template <class Epi, class Sched, bool ALIGN_EPI = false, bool SP2 = false>
__device__ __forceinline__ void gemm_phase(PG8_LAS unsigned char* lds, const Gemm g, const Sched& S, const Epi& E) {
    int tid_ = threadIdx.x; asm volatile("" : "+v"(tid_));
    const int tid = tid_, wid = __builtin_amdgcn_readfirstlane(tid >> 6), lane = tid & 63, wr = wid >> 2, wc = wid & 3, fr = lane & 15, fq = lane >> 4;
    const int K = g.K, nt = K / BK;
    unsigned voffA[2], voffB[2];
#pragma unroll
    for (int i = 0; i < 2; ++i) { int R, C; stage_rc(tid * 16 + i * 8192, R, C); const int Rb = Epi::PERM ? ((R & ~31) + perm32(R & 31)) : R;
        voffA[i] = (unsigned)(R * K + C) * 2u; voffB[i] = (unsigned)(Rb * K + C) * 2u; }
    const size_t kstep = (size_t)(BK * 2);
    const size_t hstep = (size_t)HALF * K * 2;
    const size_t tstep = 2 * hstep;
    const unsigned ldsw = (unsigned)wid * 1024u;
    const int aoff = lds_byte(wr * 64 + fr, fq * 8), boff = lds_byte(wc * 32 + fr, fq * 8);
#define PG8_SA(b, h) (((b) * 2 + (h)) * HTB)
#define PG8_SB(b, h) ((4 + (b) * 2 + (h)) * HTB)
#define PG8_STAGE(bufoff, gbase, voff) do { _Pragma("unroll") for (int _i = 0; _i < 2; ++_i) \
        __builtin_amdgcn_global_load_lds((const unsigned*)((const char*)(gbase) + (voff)[_i]), (PG8_LAS unsigned*)(lds + (bufoff) + ldsw + _i * 8192), 16, 0, 0); } while (0)
#define PG8_LDA(dst, b, h) do { _Pragma("unroll") for (int m = 0; m < 4; ++m) _Pragma("unroll") for (int k = 0; k < 2; ++k) dst[m][k] = *(const PG8_LAS bf16x8*)(lds + PG8_SA(b, h) + aoff + m * 2048 + k * 1024); } while (0)
#define PG8_LDB(dst, b, h) do { _Pragma("unroll") for (int n = 0; n < 2; ++n) _Pragma("unroll") for (int k = 0; k < 2; ++k) dst[n][k] = *(const PG8_LAS bf16x8*)(lds + PG8_SB(b, h) + boff + n * 2048 + k * 1024); } while (0)
#define PG8_MMA(ai, bj, At, Bt) do { __builtin_amdgcn_s_setprio(1); _Pragma("unroll") for (int m = 0; m < 4; ++m) _Pragma("unroll") for (int n = 0; n < 2; ++n) _Pragma("unroll") for (int k = 0; k < 2; ++k) \
        acc[ai][bj][m][n] = __builtin_amdgcn_mfma_f32_16x16x32_bf16(Bt[n][k], At[m][k], acc[ai][bj][m][n], 0, 0, 0); __builtin_amdgcn_s_setprio(0); } while (0)
#define PG8_WAIT_V(n) asm volatile("s_waitcnt vmcnt(" #n ")" ::: "memory")
#define PG8_WAIT_L(n) asm volatile("s_waitcnt lgkmcnt(" #n ")" ::: "memory")
#define PG8_BAR __builtin_amdgcn_s_barrier()
#define PG8_SCHED __builtin_amdgcn_sched_barrier(0)
    Unit cur, nxt; int ui = 0;
    if (!S.next(0, cur)) return;
    f32x4 acc[2][2][4][2];
#pragma unroll
    for (int a = 0; a < 2; ++a)
#pragma unroll
        for (int b = 0; b < 2; ++b)
#pragma unroll
            for (int m = 0; m < 4; ++m)
#pragma unroll
                for (int n = 0; n < 2; ++n) acc[a][b][m][n] = (f32x4){0.f, 0.f, 0.f, 0.f};
    bf16x8 At[4][2], B0[2][2], B1[2][2];
    const char* cA = (const char*)g.A + (size_t)cur.pm * tstep; const char* cB = (const char*)g.Bt + (size_t)cur.pn * tstep;
    S.a_ready(cur);
    if constexpr (SP2) {
        PG8_STAGE(PG8_SB(0, 0), cB, voffB); PG8_STAGE(PG8_SB(0, 1), cB + hstep, voffB); PG8_STAGE(PG8_SA(0, 0), cA, voffA); PG8_STAGE(PG8_SA(0, 1), cA + hstep, voffA);
        if (wr == 1) PG8_BAR;
        PG8_WAIT_V(2); PG8_BAR;
        PG8_STAGE(PG8_SB(1, 0), cB + kstep, voffB); PG8_STAGE(PG8_SA(1, 0), cA + kstep, voffA); PG8_STAGE(PG8_SB(1, 1), cB + hstep + kstep, voffB);
        PG8_WAIT_V(6); PG8_BAR;
    } else {
        PG8_STAGE(PG8_SB(0, 0), cB, voffB); PG8_STAGE(PG8_SA(0, 0), cA, voffA); PG8_STAGE(PG8_SB(0, 1), cB + hstep, voffB); PG8_STAGE(PG8_SA(0, 1), cA + hstep, voffA);
        if (wr == 1) PG8_BAR;
        PG8_WAIT_V(4); PG8_BAR;
        PG8_STAGE(PG8_SB(1, 0), cB + kstep, voffB); PG8_STAGE(PG8_SA(1, 0), cA + kstep, voffA); PG8_STAGE(PG8_SB(1, 1), cB + hstep + kstep, voffB);
        PG8_WAIT_V(6); PG8_BAR;
    }
    for (;;) {
        const bool has_next = S.next(ui + 1, nxt);
        const char* nA = has_next ? (const char*)g.A + (size_t)nxt.pm * tstep : cA; const char* nB = has_next ? (const char*)g.Bt + (size_t)nxt.pn * tstep : cB;
        for (int t = 0; t < nt; t += 2) {
            const bool last = (t == nt - 2);
            const char* a1 = cA + (size_t)(t + 1) * kstep;
            const char* a2 = last ? nA : cA + (size_t)(t + 2) * kstep; const char* b2 = last ? nB : cB + (size_t)(t + 2) * kstep;
            const char* a3 = a2 + kstep; const char* b3 = b2 + kstep;
            if (last && has_next) S.a_ready(nxt);
            if constexpr (SP2) {
            PG8_LDB(B0, 0, 0); PG8_LDB(B1, 0, 1); PG8_SCHED; PG8_LDA(At, 0, 0); PG8_STAGE(PG8_SA(1, 1), a1 + hstep, voffA);
            PG8_WAIT_V(8); PG8_WAIT_L(0); PG8_BAR; PG8_MMA(0, 0, At, B0); PG8_MMA(0, 1, At, B1); PG8_BAR; PG8_SCHED;
            PG8_LDA(At, 0, 1); PG8_STAGE(PG8_SB(0, 0), b2, voffB); PG8_STAGE(PG8_SB(0, 1), b2 + hstep, voffB); PG8_STAGE(PG8_SA(0, 0), a2, voffA);
            PG8_WAIT_V(8); PG8_WAIT_L(0); PG8_BAR; PG8_MMA(1, 0, At, B0); PG8_MMA(1, 1, At, B1); PG8_BAR; PG8_SCHED;
            PG8_LDB(B0, 1, 0); PG8_LDB(B1, 1, 1); PG8_SCHED; PG8_LDA(At, 1, 0); PG8_STAGE(PG8_SA(0, 1), a2 + hstep, voffA);
            PG8_WAIT_V(8); PG8_WAIT_L(0); PG8_BAR; PG8_MMA(0, 0, At, B0); PG8_MMA(0, 1, At, B1); PG8_BAR; PG8_SCHED;
            PG8_LDA(At, 1, 1); PG8_STAGE(PG8_SB(1, 0), b3, voffB); PG8_STAGE(PG8_SB(1, 1), b3 + hstep, voffB); PG8_STAGE(PG8_SA(1, 0), a3, voffA);
            PG8_WAIT_V(8); PG8_WAIT_L(0); PG8_BAR; PG8_MMA(1, 0, At, B0); PG8_MMA(1, 1, At, B1); PG8_BAR; PG8_SCHED;
            } else {
            PG8_LDB(B0, 0, 0); PG8_SCHED; PG8_LDA(At, 0, 0); PG8_STAGE(PG8_SA(1, 1), a1 + hstep, voffA);
            PG8_WAIT_L(8); PG8_BAR; PG8_WAIT_L(0); PG8_MMA(0, 0, At, B0); PG8_BAR; PG8_SCHED;
            PG8_LDB(B1, 0, 1); PG8_STAGE(PG8_SB(0, 0), b2, voffB);
            PG8_BAR; PG8_WAIT_L(0); PG8_MMA(0, 1, At, B1); PG8_BAR;
            PG8_LDA(At, 0, 1); PG8_STAGE(PG8_SA(0, 0), a2, voffA);
            PG8_BAR; PG8_WAIT_L(0); PG8_MMA(1, 0, At, B0); PG8_BAR; PG8_SCHED;
            PG8_STAGE(PG8_SB(0, 1), b2 + hstep, voffB);
            PG8_WAIT_V(6); PG8_BAR; PG8_MMA(1, 1, At, B1); PG8_BAR;
            PG8_LDB(B0, 1, 0); PG8_SCHED; PG8_LDA(At, 1, 0); PG8_STAGE(PG8_SA(0, 1), a2 + hstep, voffA);
            PG8_WAIT_L(8); PG8_BAR; PG8_WAIT_L(0); PG8_MMA(0, 0, At, B0); PG8_BAR; PG8_SCHED;
            PG8_LDB(B1, 1, 1); PG8_STAGE(PG8_SB(1, 0), b3, voffB);
            PG8_BAR; PG8_WAIT_L(0); PG8_MMA(0, 1, At, B1); PG8_BAR;
            PG8_LDA(At, 1, 1); PG8_STAGE(PG8_SA(1, 0), a3, voffA);
            PG8_BAR; PG8_WAIT_L(0); PG8_MMA(1, 0, At, B0); PG8_BAR; PG8_SCHED;
            PG8_STAGE(PG8_SB(1, 1), b3 + hstep, voffB);
            PG8_WAIT_V(6); PG8_BAR; PG8_MMA(1, 1, At, B1); PG8_BAR;
            }
        }
        if constexpr (ALIGN_EPI) { if (wr == 0) PG8_BAR; }
        if constexpr (!Epi::AFTER_DRAIN) { E(acc, cur, wr, wc, fr, fq); S.done(cur); }
        if (!has_next) break;
#pragma unroll
        for (int a = 0; a < 2; ++a)
#pragma unroll
            for (int b = 0; b < 2; ++b)
#pragma unroll
                for (int m = 0; m < 4; ++m)
#pragma unroll
                    for (int n = 0; n < 2; ++n) acc[a][b][m][n] = (f32x4){0.f, 0.f, 0.f, 0.f};
        cur = nxt; cA = nA; cB = nB; ++ui;
        if constexpr (ALIGN_EPI) { if (wr == 1) PG8_BAR; }
    }
    PG8_WAIT_V(0);
    if constexpr (!ALIGN_EPI) { if (wr == 0) PG8_BAR; }
    PG8_BAR;
    if constexpr (Epi::AFTER_DRAIN) { E.fused(acc, cur, wr, wc, fr, fq, lds, wid, lane); S.done(cur); }
#undef PG8_SA
#undef PG8_SB
#undef PG8_STAGE
#undef PG8_LDA
#undef PG8_LDB
#undef PG8_MMA
#undef PG8_WAIT_V
#undef PG8_WAIT_L
#undef PG8_BAR
#undef PG8_SCHED
}
}
namespace attn_body {
using bf16=__hip_bfloat16;
using bf16x8=__attribute__((ext_vector_type(8)))short;
using s16x4=__attribute__((ext_vector_type(4)))short;
using f32x16=__attribute__((ext_vector_type(16)))float;
using u32x4=__attribute__((ext_vector_type(4)))unsigned;
constexpr int BATCH=16,NHEAD=16,SEQ=2048,D=64,QP=2048,KP=1024;
constexpr int NW=8,QBLK=32,QB=QBLK*NW,KVBLK=64,NQB=SEQ/QB;
constexpr int ATTN_UNIT_ROWS=QB;
__device__ __forceinline__ int crow(int r,int hi){return (r&3)+8*(r>>2)+4*hi;}
#define SBAR() __builtin_amdgcn_sched_barrier(0)
__device__ __forceinline__ void cmask(f32x16&p0,f32x16&p1,int jb,int qrel,int hi){
  const float NEG=-INFINITY; int kb=64*jb+4*hi;
  #pragma unroll
  for(int r=0;r<16;++r){int kv=kb+(r&3)+8*(r>>2); if(kv>qrel)p0[r]=NEG; if(kv+32>qrel)p1[r]=NEG;}
}

constexpr int NSLOT=3, SLOTB=8192;
constexpr int LDS_K=0, LDS_V=NSLOT*SLOTB, LDS_WS=2*NSLOT*SLOTB, LDS_OST=LDS_WS+NW*64*4, LDS_BIAS=LDS_OST+NW*4096, LDS_SCAN=LDS_BIAS+SEQ*16, LDS_BYTES=LDS_SCAN+64;
constexpr float C2=0.125f*1.4426950408889634f;
__device__ __forceinline__ void glds16(const void*gsrc,unsigned lds_dst){unsigned keep;
  asm volatile("s_mov_b32 %0, m0\n\ts_mov_b32 m0, %2\n\ts_nop 0\n\tglobal_load_lds_dwordx4 %1, off\n\ts_mov_b32 m0, %0":"=&s"(keep):"v"(gsrc),"s"(lds_dst):"memory");}
__device__ __forceinline__ float max3f(float a,float b,float c){float r;asm("v_max3_f32 %0, %1, %2, %3":"=v"(r):"v"(a),"v"(b),"v"(c));return r;}
__device__ __forceinline__ float max2f(float a,float b){float r;asm("v_max_f32_e32 %0, %1, %2":"=v"(r):"v"(a),"v"(b));return r;}
__device__ __forceinline__ float fadd_s(float a,float b){float r;asm("v_add_f32_e32 %0, %1, %2":"=v"(r):"v"(a),"v"(b));return r;}
__device__ __forceinline__ float fsub_s(float a,float b){float r;asm("v_sub_f32_e32 %0, %1, %2":"=v"(r):"v"(a),"v"(b));return r;}
typedef float f32x2_t __attribute__((ext_vector_type(2))); typedef __bf16 bf16x2_t __attribute__((ext_vector_type(2)));
__device__ __forceinline__ unsigned cvtpk_s(float lo,float hi){f32x2_t v={lo,hi};bf16x2_t b=__builtin_convertvector(v,bf16x2_t);return __builtin_bit_cast(unsigned,b);}
#define WAIT_BAR(N) asm volatile("s_waitcnt vmcnt(" #N ") lgkmcnt(0)\n\ts_barrier":::"memory")

__device__ __forceinline__ void qkt(f32x16&p0,f32x16&p1,const char*Kslot,const bf16x8*qr,int r32,int hi,bf16x8 kb0,bf16x8 kb1,bf16x8 qone){ const f32x16 negm=f32x16{};
  p0=__builtin_amdgcn_mfma_f32_32x32x16_bf16(kb0,qone,negm,0,0,0);p1=__builtin_amdgcn_mfma_f32_32x32x16_bf16(kb1,qone,negm,0,0,0);
  const char*kb=Kslot+hi*1024+r32*16;
  #pragma unroll
  for(int d0=0;d0<4;++d0){
    const bf16x8 b0=*reinterpret_cast<const bf16x8*>(kb+d0*2048);
    const bf16x8 b1=*reinterpret_cast<const bf16x8*>(kb+d0*2048+512);
    {p0=__builtin_amdgcn_mfma_f32_32x32x16_bf16(b0,qr[d0],p0,0,0,0);p1=__builtin_amdgcn_mfma_f32_32x32x16_bf16(b1,qr[d0],p1,0,0,0);}}
}
typedef __attribute__((address_space(3))) const char* lds_cptr;
typedef short v4i16_t __attribute__((ext_vector_type(4)));
__device__ __forceinline__ void kload8(bf16x8*kf,lds_cptr kp){
  kf[0]=*(const __attribute__((address_space(3))) bf16x8*)(kp);      kf[1]=*(const __attribute__((address_space(3))) bf16x8*)(kp+512);
  kf[2]=*(const __attribute__((address_space(3))) bf16x8*)(kp+2048); kf[3]=*(const __attribute__((address_space(3))) bf16x8*)(kp+2560);
  kf[4]=*(const __attribute__((address_space(3))) bf16x8*)(kp+4096); kf[5]=*(const __attribute__((address_space(3))) bf16x8*)(kp+4608);
  kf[6]=*(const __attribute__((address_space(3))) bf16x8*)(kp+6144); kf[7]=*(const __attribute__((address_space(3))) bf16x8*)(kp+6656);
}
__device__ __forceinline__ void kload2(bf16x8*kf,lds_cptr kp,int j){ kf[2*j]=*(const __attribute__((address_space(3))) bf16x8*)(kp+j*2048); kf[2*j+1]=*(const __attribute__((address_space(3))) bf16x8*)(kp+j*2048+512); }
__device__ __forceinline__ s16x4 vtr(lds_cptr p){ return __builtin_bit_cast(s16x4,__builtin_amdgcn_ds_read_tr16_b64_v4i16((__attribute__((address_space(3))) v4i16_t*)p)); }
__device__ __forceinline__ float rowmax(const f32x16&p0,const f32x16&p1){
  float a=max3f(p0[0],p0[1],p1[0]),b=max3f(p0[2],p0[3],p1[1]);a=max3f(a,p1[2],p1[3]);
  #pragma unroll
  for(int r=4;r<16;r+=4){a=max3f(a,p0[r],p0[r+1]);b=max3f(b,p0[r+2],p0[r+3]);a=max3f(a,p1[r],p1[r+1]);b=max3f(b,p1[r+2],p1[r+3]);}
  const float m=max2f(a,b);
  auto rr=__builtin_amdgcn_permlane32_swap(__float_as_uint(m),__float_as_uint(m),false,false);
  return max2f(__uint_as_float(rr[0]),__uint_as_float(rr[1]));
}
__device__ __forceinline__ void pv(f32x16*o,int vb,bf16x8 pa0,bf16x8 pa1,bf16x8 pa2,bf16x8 pa3){
  #pragma unroll
  for(int d0=0;d0<2;++d0){s16x4 lo[4],hi[4];
    #pragma unroll
    for(int ks=0;ks<4;++ks){
      asm volatile("ds_read_b64_tr_b16 %0,%1 offset:%c2":"=&v"(lo[ks]):"v"(vb),"i"(d0*4096+ks*1024):"memory");
      asm volatile("ds_read_b64_tr_b16 %0,%1 offset:%c2":"=&v"(hi[ks]):"v"(vb),"i"(d0*4096+ks*1024+512):"memory");}
    asm volatile("s_waitcnt lgkmcnt(0)":::"memory");SBAR();
    #define PK(k) (bf16x8){lo[k][0],lo[k][1],lo[k][2],lo[k][3],hi[k][0],hi[k][1],hi[k][2],hi[k][3]}
    o[d0]=__builtin_amdgcn_mfma_f32_32x32x16_bf16(pa0,PK(0),o[d0],0,0,0);
    o[d0]=__builtin_amdgcn_mfma_f32_32x32x16_bf16(pa1,PK(1),o[d0],0,0,0);
    o[d0]=__builtin_amdgcn_mfma_f32_32x32x16_bf16(pa2,PK(2),o[d0],0,0,0);
    o[d0]=__builtin_amdgcn_mfma_f32_32x32x16_bf16(pa3,PK(3),o[d0],0,0,0);
    #undef PK
  }
}

#ifndef ATTN_STORE16
#define ATTN_STORE16(p,v) (*(u32x4*)(p)=(v))
#endif
template<int THRL> __device__ __forceinline__ void attn_unit(int b,int h,int qb,const bf16*Q,const bf16*__restrict__ K,const bf16*__restrict__ V,const bf16*__restrict__ ZA,bf16*O,char*shm){
  int tid_=threadIdx.x; asm volatile("":"+v"(tid_));
  const int tid=tid_,lane=tid&63,r32=lane&31,hi=lane>>5; const int wid=__builtin_amdgcn_readfirstlane(tid>>6);
  const long rowbase=(long)b*SEQ; const int q0=qb*QB;
  const bf16*Qw=Q+(rowbase+q0+wid*QBLK)*QP+h*D;
  const bf16*Kh=K+rowbase*KP+h*D,*Vh=V+rowbase*KP+h*D;
  const unsigned lds0=(unsigned)(uintptr_t)shm;
  float*wsf=(float*)(shm+LDS_WS)+wid*64;
  const bf16*ksrc=Kh+(long)lane*KP+wid*8;
  const bf16*vsrc=Vh+(long)(16*(wid&3)+(lane>>2))*KP+(wid>>2)*32+(lane&3)*8;
  const unsigned kdst=lds0+LDS_K+wid*1024, vdst=lds0+LDS_V+wid*1024;
  #define TT(i) (((i)<4)?(NT-4+(i)):(NT-1-(i)))
  #define DMA_K(t,slot) glds16(ksrc+(long)TT(t)*KVBLK*KP,(unsigned)__builtin_amdgcn_readfirstlane(kdst+(slot)))
  #define DMA_V(t,slot) glds16(vsrc+(long)TT(t)*KVBLK*KP,(unsigned)__builtin_amdgcn_readfirstlane(vdst+(slot)))
  const int vb0=(int)(lds0+LDS_V)+((lane>>4)&1)*32+(lane&3)*8+(4*hi+((lane&15)>>2))*64;
  const char*Kbase=shm+LDS_K; bf16x8 kf[8];
  const lds_cptr shm3=(lds_cptr)shm; const lds_cptr kp0=shm3+LDS_K+hi*1024+r32*16; const lds_cptr vp0=shm3+LDS_V+((lane>>4)&1)*32+(lane&3)*8+(4*hi+((lane&15)>>2))*64;
  const lds_cptr bp0=shm3+LDS_BIAS+r32*16;
  u32x4 qone_w; qone_w=(hi==0)?(u32x4){0x3F803F80u,0x00003F80u,0u,0u}:(u32x4){0u,0u,0u,0u}; asm volatile("":"+v"(qone_w));
  #define qone __builtin_bit_cast(bf16x8,qone_w)
  #define SETREF() do{ const float nm_=-mhat; unsigned a_=__builtin_bit_cast(unsigned,nm_); const unsigned h0_=(a_+0x7fffu+((a_>>16)&1u))>>16; const float r1_=nm_-__builtin_bit_cast(float,h0_<<16); \
      unsigned b_=__builtin_bit_cast(unsigned,r1_); const unsigned h1_=(b_+0x7fffu+((b_>>16)&1u))>>16; const float r2_=r1_-__builtin_bit_cast(float,h1_<<16); \
      unsigned c_=__builtin_bit_cast(unsigned,r2_); const unsigned h2_=(c_+0x7fffu+((c_>>16)&1u))>>16; \
      if(hi==0){ qone_w[1]=0x3F80u|(h0_<<16); qone_w[2]=(h1_&0xffffu)|(h2_<<16); } asm volatile("":"+v"(qone_w)); }while(0)
  #define KBL(i,n) (*(const __attribute__((address_space(3))) bf16x8*)(bp0+TT(i)*1024+(n)*512))
  const int NT=(q0+QB)/KVBLK;
  DMA_K(0,0);DMA_V(0,0);DMA_K(1,SLOTB);
  bf16x8 qr[4];
  #pragma unroll
  for(int d0=0;d0<4;++d0)qr[d0]=*reinterpret_cast<const bf16x8*>(&Qw[(long)r32*QP+d0*16+hi*8]);
  float mhat=0.f,l_reg=0.f;f32x16 o[2];o[0]=f32x16{};o[1]=f32x16{};
  const int qrel=wid*QBLK+r32;
  #define CMASK(P0,P1,t) do{ if((t)<4)cmask(P0,P1,(t),qrel,hi);}while(0)
  bool resc=false;
  #define START(P0,P1) do{ const float rm=rowmax(P0,P1); resc=false; \
    { const float dl=rm; mhat=fadd_s(mhat,dl); \
      _Pragma("unroll") for(int r=0;r<16;++r){P0[r]=fsub_s(P0[r],dl);P1[r]=fsub_s(P1[r],dl);} \
      SETREF(); } \
    _Pragma("unroll") for(int r=0;r<16;++r)P0[r]=__builtin_amdgcn_exp2f(P0[r]); }while(0)
  #define RESC() do{ if(resc){ asm volatile("s_waitcnt lgkmcnt(0)":::"memory"); \
      _Pragma("unroll") for(int d_=0;d_<2;++d_) _Pragma("unroll") for(int r=0;r<16;++r)o[d_][r]*=wsf[crow(r,hi)]; } }while(0)
  f32x16 pA0,pA1,pB0,pB1;
  int sl_prev=0,sl_cur=0,sl_next=SLOTB;
  #define ROT() do{sl_prev=sl_cur;sl_cur=sl_next;sl_next=(sl_next==(NSLOT-1)*SLOTB)?0:sl_next+SLOTB;}while(0)
  DMA_K(2,2*SLOTB);
  WAIT_BAR(3);
  { const bf16x8 kb0_=KBL(0,0),kb1_=KBL(0,1); qkt(pA0,pA1,Kbase,qr,r32,hi,kb0_,kb1_,qone); } asm volatile("s_nop 15\n\ts_nop 7":"+v"(pA0),"+v"(pA1));CMASK(pA0,pA1,0);
  START(pA0,pA1);
  _Pragma("unroll") for(int r=0;r<16;++r)pA1[r]=__builtin_amdgcn_exp2f(pA1[r]);
  WAIT_BAR(0);
  DMA_K(3,0);DMA_V(1,SLOTB);
  ROT();
  kload8(kf,kp0+sl_cur);
  WAIT_BAR(2);
  s16x4 vlo[8],vhi[8]; u32x4 pw0,pw1,pw2,pw3;
  #define PKW(P,B) cvtpk_s(P[B],P[B+1])
  #define PAF(k) __builtin_bit_cast(bf16x8,pw##k)
  #define VFR(i) (bf16x8){vlo[i][0],vlo[i][1],vlo[i][2],vlo[i][3],vhi[i][0],vhi[i][1],vhi[i][2],vhi[i][3]}
  #define PIN(x) asm volatile("":"+v"(x))
  #define MX3(a,b,c) __builtin_fmaxf(__builtin_fmaxf((a),(b)),(c))
  #define GAPA(MF,A0,A1,A2,A3,W0,W1,PW) do{ MF; sacc+=A0; sacc+=A1; sacc+=A2; sacc+=A3; PIN(sacc); W0; W1; PIN(PW); SBAR(); }while(0)
  #define EX(v) __builtin_amdgcn_exp2f(v)
  #define GAPB(MF,X,B) do{ MF; X[B]=EX(X[B]); X[B+1]=EX(X[B+1]); X[B+2]=EX(X[B+2]); X[B+3]=EX(X[B+3]); PIN(X); SBAR(); }while(0)
  #define VRD(i) do{ vlo[i]=vtr(vp_+(((i)>>2)*4096+((i)&3)*1024)); vhi[i]=vtr(vp_+(((i)>>2)*4096+((i)&3)*1024+512)); }while(0)
  #define KRD(G,j) do{ if(G){ kload2(kf,kp0+sl_next,j); SBAR(); } }while(0)
  #define STEP(C0,C1,P0,P1,t,GK,GV,GL) do{ SBAR(); \
    const lds_cptr vp_=vp0+sl_prev; \
    { const bf16x8 kb0_=KBL(t,0),kb1_=KBL(t,1); VRD(0); SBAR(); C0=__builtin_amdgcn_mfma_f32_32x32x16_bf16(kb0_,qone,f32x16{},0,0,0); C1=__builtin_amdgcn_mfma_f32_32x32x16_bf16(kb1_,qone,f32x16{},0,0,0); SBAR(); } \
    float sacc=(P0[0]+P0[1]); \
    GAPA(C0=__builtin_amdgcn_mfma_f32_32x32x16_bf16(kf[0],qr[0],C0,0,0,0), P0[2],P0[3],P0[4],P0[5],     pw0[0]=PKW(P0,0), pw0[1]=PKW(P0,2), pw0); \
    VRD(4); SBAR(); GAPA(C1=__builtin_amdgcn_mfma_f32_32x32x16_bf16(kf[1],qr[0],C1,0,0,0), P0[6],P0[7],P0[8],P0[9],     pw0[2]=PKW(P0,4), pw0[3]=PKW(P0,6), pw0); \
    VRD(1); SBAR(); GAPA(C0=__builtin_amdgcn_mfma_f32_32x32x16_bf16(kf[2],qr[1],C0,0,0,0),   P0[10],P0[11],P0[12],P0[13], pw1[0]=PKW(P0,8), pw1[1]=PKW(P0,10), pw1); \
    VRD(5); SBAR(); GAPA(C1=__builtin_amdgcn_mfma_f32_32x32x16_bf16(kf[3],qr[1],C1,0,0,0),   P0[14],P0[15],P1[0],P1[1],   pw1[2]=PKW(P0,12),pw1[3]=PKW(P0,14), pw1); \
    VRD(2); SBAR(); GAPA(C0=__builtin_amdgcn_mfma_f32_32x32x16_bf16(kf[4],qr[2],C0,0,0,0),   P1[2],P1[3],P1[4],P1[5],     pw2[0]=PKW(P1,0), pw2[1]=PKW(P1,2), pw2); \
    VRD(6); SBAR(); GAPA(C1=__builtin_amdgcn_mfma_f32_32x32x16_bf16(kf[5],qr[2],C1,0,0,0),   P1[6],P1[7],P1[8],P1[9],     pw2[2]=PKW(P1,4), pw2[3]=PKW(P1,6), pw2); \
    VRD(3); SBAR(); GAPA(C0=__builtin_amdgcn_mfma_f32_32x32x16_bf16(kf[6],qr[3],C0,0,0,0),   P1[10],P1[11],P1[12],P1[13], pw3[0]=PKW(P1,8), pw3[1]=PKW(P1,10), pw3); \
    VRD(7); SBAR(); GAPA(C1=__builtin_amdgcn_mfma_f32_32x32x16_bf16(kf[7],qr[3],C1,0,0,0),   P1[14],P1[15],0.f,0.f,       pw3[2]=PKW(P1,12),pw3[3]=PKW(P1,14), pw3); \
    l_reg+=sacc; \
    if(GK){DMA_K((t)+3,sl_cur);} if(GV){DMA_V((t)+1,sl_next);} \
    CMASK(C0,C1,t); \
    { float a=MX3(C0[0],C0[1],C1[0]),b=MX3(C0[2],C0[3],C1[1]); a=MX3(a,C1[2],C1[3]); \
      _Pragma("unroll") for(int r=4;r<16;r+=4){a=MX3(a,C0[r],C0[r+1]);b=MX3(b,C0[r+2],C0[r+3]);a=MX3(a,C1[r],C1[r+1]);b=MX3(b,C1[r+2],C1[r+3]);} \
      float rm=__builtin_fmaxf(a,b); { auto rr=__builtin_amdgcn_permlane32_swap(__float_as_uint(rm),__float_as_uint(rm),false,false); rm=__builtin_fmaxf(__uint_as_float(rr[0]),__uint_as_float(rr[1])); } \
      resc=false; \
      if(__builtin_expect(__any(rm>(float)THRL),0)){ const float dl=__builtin_fmaxf(rm,0.f); mhat+=dl; \
        _Pragma("unroll") for(int r=0;r<16;++r){C0[r]-=dl;C1[r]-=dl;} \
        SETREF(); \
        const float f=__builtin_amdgcn_exp2f(-dl); l_reg*=f; if(hi==0)wsf[r32]=f; resc=true; } } \
    SBAR(); \
    GAPB(o[0]=__builtin_amdgcn_mfma_f32_32x32x16_bf16(PAF(0),VFR(0),o[0],0,0,0), C0,0); \
    GAPB(o[1]=__builtin_amdgcn_mfma_f32_32x32x16_bf16(PAF(0),VFR(4),o[1],0,0,0), C0,4); \
    KRD(GL,0); GAPB(o[0]=__builtin_amdgcn_mfma_f32_32x32x16_bf16(PAF(1),VFR(1),o[0],0,0,0), C0,8); \
    KRD(GL,1); GAPB(o[1]=__builtin_amdgcn_mfma_f32_32x32x16_bf16(PAF(1),VFR(5),o[1],0,0,0), C0,12); \
    KRD(GL,2); GAPB(o[0]=__builtin_amdgcn_mfma_f32_32x32x16_bf16(PAF(2),VFR(2),o[0],0,0,0), C1,0); \
    KRD(GL,3); GAPB(o[1]=__builtin_amdgcn_mfma_f32_32x32x16_bf16(PAF(2),VFR(6),o[1],0,0,0), C1,4); \
    GAPB(o[0]=__builtin_amdgcn_mfma_f32_32x32x16_bf16(PAF(3),VFR(3),o[0],0,0,0), C1,8); \
    GAPB(o[1]=__builtin_amdgcn_mfma_f32_32x32x16_bf16(PAF(3),VFR(7),o[1],0,0,0), C1,12); \
    }while(0)
  int t=1;
  #define ENDW(tt) do{ if((tt)+3<NT){WAIT_BAR(2);} else if((tt)+2<NT){WAIT_BAR(1);} else {WAIT_BAR(0);} }while(0)
  for(;t+1<NT&&t<5;t+=2){
    STEP(pB0,pB1,pA0,pA1,t,(t+3<NT),(t+1<NT),(t+1<NT));       ENDW(t);   RESC(); ROT();
    STEP(pA0,pA1,pB0,pB1,t+1,(t+4<NT),(t+2<NT),(t+2<NT));     ENDW(t+1); RESC(); ROT();
  }
  #undef CMASK
  #define CMASK(P0,P1,t) do{}while(0)
  for(;t+5<NT;t+=2){
    STEP(pB0,pB1,pA0,pA1,t,true,true,true);     WAIT_BAR(2); RESC(); ROT();
    STEP(pA0,pA1,pB0,pB1,t+1,true,true,true);   WAIT_BAR(2); RESC(); ROT();
  }
  for(;t+1<NT;t+=2){
    STEP(pB0,pB1,pA0,pA1,t,(t+3<NT),(t+1<NT),(t+1<NT));       ENDW(t);   RESC(); ROT();
    STEP(pA0,pA1,pB0,pB1,t+1,(t+4<NT),(t+2<NT),(t+2<NT));     ENDW(t+1); RESC(); ROT();
  }
  #undef CMASK
  #define CMASK(P0,P1,t) do{ if((t)<4)cmask(P0,P1,(t),qrel,hi);}while(0)
  STEP(pB0,pB1,pA0,pA1,NT-1,false,false,false); RESC();
  { float sacc=pB0[0]+pB0[1]; _Pragma("unroll") for(int r=2;r<16;++r)sacc+=pB0[r]; _Pragma("unroll") for(int r=0;r<16;++r)sacc+=pB1[r]; l_reg+=sacc;
    pw0=(u32x4){PKW(pB0,0),PKW(pB0,2),PKW(pB0,4),PKW(pB0,6)};pw1=(u32x4){PKW(pB0,8),PKW(pB0,10),PKW(pB0,12),PKW(pB0,14)};pw2=(u32x4){PKW(pB1,0),PKW(pB1,2),PKW(pB1,4),PKW(pB1,6)};pw3=(u32x4){PKW(pB1,8),PKW(pB1,10),PKW(pB1,12),PKW(pB1,14)};
    SBAR(); pv(o,vb0+sl_cur,PAF(0),PAF(1),PAF(2),PAF(3)); }
  #undef PKW
  #undef PAF
  #undef VFR
  #undef PIN
  #undef MX3
  #undef GAPA
  #undef GAPB
  #undef EX
  #undef VRD
  #undef KRD
  #undef STEP
  #undef ENDW
  {auto rr=__builtin_amdgcn_permlane32_swap(__float_as_uint(l_reg),__float_as_uint(l_reg),false,false);l_reg=__uint_as_float(rr[0])+__uint_as_float(rr[1]);}
  if(hi==0)wsf[32+r32]=l_reg;asm volatile("s_waitcnt lgkmcnt(0)":::"memory");
  float rli[16];
  #pragma unroll
  for(int r=0;r<16;++r)rli[r]=__builtin_amdgcn_rcpf(wsf[32+crow(r,hi)]);
  bf16*Ow=O+(rowbase+q0+wid*QBLK)*QP+h*D; const unsigned short*Zw=(const unsigned short*)(ZA+(rowbase+q0+wid*QBLK)*KP+h*D);
  { float*stgf=(float*)(shm+LDS_OST)+wid*1024;
    unsigned short*Ou=(unsigned short*)Ow; int lane_e=lane; asm volatile("":"+v"(lane_e));
    #pragma unroll
    for(int d0=0;d0<2;++d0){
      #pragma unroll
      for(int r=0;r<16;++r)stgf[crow(r,hi)*32+r32]=o[d0][r]*rli[r];
      asm volatile("s_waitcnt lgkmcnt(0)":::"memory");
      #pragma unroll
      for(int i=0;i<4;++i){const int row=i*8+(lane_e>>3),ch=lane_e&7;
        const float4 v=*(const float4*)(stgf+row*32+ch*4);
        const uint2 zw=*(const uint2*)(Zw+(long)row*KP+d0*32+ch*4);
        uint2 w; w.x=cvtpk_s(v.x*__builtin_bit_cast(float,zw.x<<16),v.y*__builtin_bit_cast(float,zw.x&0xffff0000u)); w.y=cvtpk_s(v.z*__builtin_bit_cast(float,zw.y<<16),v.w*__builtin_bit_cast(float,zw.y&0xffff0000u));
        *(uint2*)(Ou+(long)row*QP+d0*32+ch*4)=w;}
      asm volatile("s_waitcnt lgkmcnt(0)":::"memory");
    } }
  asm volatile("s_waitcnt lgkmcnt(0)\n\ts_barrier":::"memory");
  #undef DMA_K
  #undef TT
  #undef KBL
  #undef qone
  #undef SETREF
  #undef DMA_V
  #undef CMASK
  #undef START
  #undef RESC
  #undef ROT
}
constexpr int ATTN_LDS_BYTES=LDS_BYTES;
struct AttnTensors { const bf16* Q; const bf16* K; const bf16* V; const bf16* ZA; bf16* O; const float* LF; };
__device__ __forceinline__ void build_bias(const float* LFbh, char* shm){
  int tid_=threadIdx.x; asm volatile("":"+v"(tid_)); const int tid=tid_,lane=tid&63,wid=tid>>6;
  const float4 v=*(const float4*)(LFbh+tid*4);
  const float c0=v.x,c1=c0+v.y,c2=c1+v.z,c3=c2+v.w; float s=c3;
  #pragma unroll
  for(int o=1;o<64;o<<=1){const float n=__shfl_up(s,o); if(lane>=o)s+=n;}
  float*part=(float*)(shm+LDS_SCAN);
  if(lane==63)part[wid]=s;
  __syncthreads();
  float base=0.f; for(int w=0;w<wid;++w)base+=part[w];
  const float ex=base+s-c3; const float cc[4]={ex+c0,ex+c1,ex+c2,ex+c3};
  #pragma unroll
  for(int e=0;e<4;++e){ const float bv=-cc[e]*1.4426950408889634f;
    unsigned u0=__builtin_bit_cast(unsigned,bv); const unsigned h0=(u0+0x7fffu+((u0>>16)&1u))>>16; const float r1=bv-__builtin_bit_cast(float,h0<<16);
    unsigned u1=__builtin_bit_cast(unsigned,r1); const unsigned h1=(u1+0x7fffu+((u1>>16)&1u))>>16; const float r2=r1-__builtin_bit_cast(float,h1<<16);
    unsigned u2=__builtin_bit_cast(unsigned,r2); const unsigned h2=(u2+0x7fffu+((u2>>16)&1u))>>16;
    *(u32x4*)(shm+LDS_BIAS+(tid*4+e)*16)=(u32x4){(h0&0xffffu)|(h1<<16),(h2&0xffffu)|0x3F800000u,0x3F803F80u,0u}; }
  __syncthreads();
}
template<int THRL=8> __device__ __forceinline__ void attn_phase(char*lds,const AttnTensors&T,int vcu,int ncu){
  for(int bh=vcu;bh<BATCH*NHEAD;bh+=ncu){
    build_bias(T.LF+(size_t)bh*SEQ,lds);
    for(int i=0;i<NQB;++i) attn_unit<THRL>(bh/NHEAD,bh%NHEAD,NQB-1-i,T.Q,T.K,T.V,T.ZA,T.O,lds);
  }
}
#undef SBAR
#undef WAIT_BAR
}
constexpr int NWAVES = 8;
constexpr int NCU = 256;
constexpr int RING_OFF = 0, RING_BYTES = 131072;
constexpr int LDSCTL_OFF = RING_BYTES, MISC_OFF = LDSCTL_OFF + 320;
constexpr int LDS_BYTES = 147456;
constexpr int CW_BAR = 4096, BAR_STRIDE = 4096;
constexpr int MAX_LAUNCHES = 24;
static_assert((CW_BAR + MAX_LAUNCHES * BAR_STRIDE) * 4 <= (int)CTL_ZERO_BYTES, "barrier regions inside the memset region");
constexpr int NPHASE = 1 + 5 * DEPTH;

#define GAS __attribute__((address_space(1)))
#define LAS __attribute__((address_space(3)))
typedef GAS unsigned gu32;
#define RLX_AGENT __ATOMIC_RELAXED, __HIP_MEMORY_SCOPE_AGENT
#define LDS_WAIT() asm volatile("s_waitcnt lgkmcnt(0)" ::: "memory")
#define VM_WAIT() asm volatile("s_waitcnt vmcnt(0)" ::: "memory")
#define XB_TMO      128
#define XB_XCNT(j)  (256  + 64 * (j))
#define XB_XSUB(j)  (1280 + 64 * (j))
#define XB_XGEN(j)  (2304 + 64 * (j))
#define XB_TOP      3328
#define XB_TOPGEN   3392
#define XCD_BAR_WORDS 3456
#define XB_SPIN_CAP (1u << 18)

__device__ __forceinline__ unsigned xb_ld(unsigned* p)              { return __hip_atomic_load(p, __ATOMIC_RELAXED, __HIP_MEMORY_SCOPE_AGENT); }
__device__ __forceinline__ unsigned xb_add(unsigned* p, unsigned v) { return __hip_atomic_fetch_add(p, v, __ATOMIC_RELAXED, __HIP_MEMORY_SCOPE_AGENT); }
__device__ __forceinline__ unsigned xb_xcc_id() { return (unsigned)__builtin_amdgcn_s_getreg((3 << 11) | 20) & 0xFu; }
#define XB_SPIN(cond, bar) do { unsigned _sp = 0; while (cond) { __builtin_amdgcn_s_sleep(1); \
    if ((++_sp & 255u) == 0u) { if (xb_ld(&(bar)[XB_TMO])) break; if (_sp > XB_SPIN_CAP) { atomicAdd(&(bar)[XB_TMO], 1u); break; } } } } while (0)

struct XcdBarrier {
    unsigned* bar; unsigned x;
    volatile LAS unsigned* st;
};

__device__ __forceinline__ XcdBarrier xcd_barrier_post(unsigned* bar, volatile LAS unsigned* st) {
    XcdBarrier b; b.bar = bar; b.x = xb_xcc_id(); b.st = st;
    if (threadIdx.x == 0) (void)xb_add(&bar[XB_XCNT(b.x)], 1u);
    return b;
}
__device__ __forceinline__ void xcd_barrier_complete(unsigned* bar, unsigned x, unsigned& nloc, unsigned& nx) {
    const unsigned G = gridDim.x * gridDim.y * gridDim.z;
    unsigned sum, cnt, mine, sp = 0u;
    for (;;) {
        sum = 0u; cnt = 0u; mine = 0u;
#pragma unroll
        for (unsigned j = 0; j < 16; ++j) { const unsigned c = xb_ld(&bar[XB_XCNT(j)]); sum += c; cnt += (c > 0u) ? 1u : 0u; mine = (j == x) ? c : mine; }
        if (sum == G) break;
        __builtin_amdgcn_s_sleep(1);
        if ((++sp & 255u) == 0u) { if (xb_ld(&bar[XB_TMO])) break; if (sp > XB_SPIN_CAP) { atomicAdd(&bar[XB_TMO], 1u); break; } }
    }
    nloc = mine > 0u ? mine : 1u; nx = cnt > 0u ? cnt : 1u;
}

__device__ __forceinline__ void xcd_barrier(const XcdBarrier& b) {
    asm volatile("s_waitcnt vmcnt(0)" ::: "memory");
    __syncthreads();
    if (threadIdx.x == 0) {
        unsigned* bar = b.bar;
        __builtin_amdgcn_s_waitcnt(0);
        unsigned nloc = b.st[0], nx = b.st[1];
        if (nloc == 0u) { xcd_barrier_complete(bar, b.x, nloc, nx); b.st[0] = nloc; b.st[1] = nx; }
        const unsigned old = xb_add(&bar[XB_XSUB(b.x)], 1u);
        const unsigned gen = old / nloc;
        if (old + 1u == (gen + 1u) * nloc) {
            __builtin_amdgcn_fence(__ATOMIC_RELEASE, "agent");
            asm volatile("s_waitcnt vmcnt(0)" ::: "memory");
            const unsigned og = xb_add(&bar[XB_TOP], 1u);
            const unsigned tg = og / nx;
            if (og + 1u == (tg + 1u) * nx) xb_add(&bar[XB_TOPGEN], 1u);
            else XB_SPIN(xb_ld(&bar[XB_TOPGEN]) == tg, bar);
            __builtin_amdgcn_fence(__ATOMIC_ACQUIRE, "agent");
            xb_add(&bar[XB_XGEN(b.x)], 1u);
            asm volatile("s_waitcnt vmcnt(0)" ::: "memory");
        } else {
            XB_SPIN(xb_ld(&bar[XB_XGEN(b.x)]) == gen, bar);
            __builtin_amdgcn_fence(__ATOMIC_ACQUIRE, "agent");
            asm volatile("s_waitcnt vmcnt(0)" ::: "memory");
        }
    }
    __syncthreads();
}
struct Args { const float* in[11]; float* out; unsigned char* ws; int ph_lo, ph_hi, li, pad; };
struct Frame {
    LAS unsigned char* lds; volatile LAS unsigned* MISC; gu32* ctl;
    int tid, lane, wave, vcu, G;
};
__device__ __forceinline__ void p0_transpose_item(const float* W, int K, int N, int ldn, int n0, const float* gk, bf16_t* WT, LAS float* scr, int item, int lane) {
    const int nblk = N / 32, kb = item / nblk, nb = item % nblk, k0 = 64 * kb, nn0 = 32 * nb;
#pragma unroll 8
    for (int i = 0; i < 32; ++i) { const int kk = 2 * i + (lane >> 5); float v = W[(size_t)(k0 + kk) * ldn + n0 + nn0 + (lane & 31)]; if (gk) v *= gk[k0 + kk]; scr[kk * 33 + (lane & 31)] = v; }
    LDS_WAIT(); asm volatile("" ::: "memory");
    const int c = lane & 7;
#pragma unroll
    for (int j = 0; j < 4; ++j) { const int n = (lane >> 3) + 8 * j; const LAS float* s = scr + (8 * c) * 33 + n;
        u32x4 o; o.x = pk2(s[0 * 33], s[1 * 33]); o.y = pk2(s[2 * 33], s[3 * 33]); o.z = pk2(s[4 * 33], s[5 * 33]); o.w = pk2(s[6 * 33], s[7 * 33]);
        *(GAS u32x4*)(WT + (size_t)(nn0 + n) * K + k0 + 8 * c) = o; }
    LDS_WAIT(); asm volatile("" ::: "memory");
}
__device__ __forceinline__ void p0_prologue(Frame& F, const Args& a) {
    unsigned char* ws = a.ws;
    const float* x = a.in[0]; const float* norm_pre = a.in[2]; const float* w_in = a.in[4]; const float* w_pool = a.in[6]; const float* w_out = a.in[8]; const float* w_pg = a.in[9]; const float* w_pe = a.in[10];
    bf16_t* WIN = (bf16_t*)(ws + WS_WIN); bf16_t* WF = (bf16_t*)(ws + WS_WF); bf16_t* WOUT = (bf16_t*)(ws + WS_WOUT); bf16_t* WPG = (bf16_t*)(ws + WS_WPG); bf16_t* WPE = (bf16_t*)(ws + WS_WPE);
    bf16_t* HB = (bf16_t*)(ws + WS_HB); float* RSS = (float*)(ws + WS_RSS);
    { const int half = F.tid >> 8, ht = F.tid & 255, tx = ht & 15, ty = ht >> 4;
      LAS float* As = (LAS float*)(F.lds + half * 32768); LAS float* Bs = As + 16 * 65;
      for (int base = 0; base < 512; base += 2 * F.G) {
          const int task = base + 2 * F.vcu + half; const bool valid = task < 512;
          const int l = (task >> 8) & 1, g = (task >> 6) & 3, k0 = ((task >> 2) & 15) * 64, n0 = (task & 3) * 64;
          const float* W = w_in + (size_t)l * DM * INC; const float* P = w_pool + (size_t)l * 4 * 256 * 256; const float* gk = norm_pre + l * DM;
          float acc[4][4];
#pragma unroll
          for (int i = 0; i < 4; ++i)
#pragma unroll
              for (int q = 0; q < 4; ++q) acc[i][q] = 0.f;
          for (int j0 = 0; j0 < 256; j0 += 16) {
              if (valid) {
                  for (int i = ht; i < 64 * 16; i += 256) { const int kk = i >> 4, jj = i & 15; As[jj * 65 + kk] = W[(size_t)(k0 + kk) * INC + 4112 + 256 * g + j0 + jj]; }
                  for (int i = ht; i < 16 * 64; i += 256) { const int jj = i >> 6, nn = i & 63; Bs[jj * 64 + nn] = P[((size_t)g * 256 + j0 + jj) * 256 + n0 + nn]; }
              }
              __syncthreads();
              if (valid) {
#pragma unroll
                  for (int jj = 0; jj < 16; ++jj) { float av[4], bv[4];
#pragma unroll
                      for (int i = 0; i < 4; ++i) { av[i] = As[jj * 65 + ty * 4 + i]; bv[i] = Bs[jj * 64 + tx * 4 + i]; }
#pragma unroll
                      for (int i = 0; i < 4; ++i)
#pragma unroll
                          for (int q = 0; q < 4; ++q) acc[i][q] += av[i] * bv[q]; }
              }
              __syncthreads();
          }
          if (valid) { float gs[4];
#pragma unroll
              for (int i = 0; i < 4; ++i) gs[i] = gk[k0 + ty * 4 + i];
              bf16_t* dst = WIN + (size_t)l * NIN * DM;
#pragma unroll
              for (int q = 0; q < 4; ++q) { u32x2 o; o.x = pk2(acc[0][q] * gs[0], acc[1][q] * gs[1]); o.y = pk2(acc[2][q] * gs[2], acc[3][q] * gs[3]);
                  *(GAS u32x2*)(dst + (size_t)(4096 + 256 * g + n0 + tx * 4 + q) * DM + k0 + ty * 4) = o; } }
      }
    }
    __syncthreads();
    { LAS float* scr = (LAS float*)(F.lds + F.wave * 16384);
      const int gw = F.vcu * NWAVES + F.wave, NGW = F.G * NWAVES;
      constexpr int I0 = 2048, I1 = 512, I2 = 1024, I3 = 512, I4 = 128, IL = I0 + I1 + I2 + I3 + I4;
      for (int it = gw; it < DEPTH * IL; it += NGW) {
          const int l = it / IL; int r = it % IL;
          const float* wi = w_in + (size_t)l * DM * INC; const float* gk = norm_pre + l * DM; bf16_t* wt = WIN + (size_t)l * NIN * DM;
          if (r < I0) { p0_transpose_item(wi, DM, 4096, INC, 0, gk, wt, scr, r, F.lane); continue; } r -= I0;
          if (r < I1) { p0_transpose_item(wi, DM, 1024, INC, 5136, gk, wt + (size_t)5120 * DM, scr, r, F.lane); continue; } r -= I1;
          if (r < I2) { p0_transpose_item(w_out + (size_t)l * MIXW * DM, MIXW, DM, DM, 0, nullptr, WOUT + (size_t)l * DM * MIXW, scr, r, F.lane); continue; } r -= I2;
          if (r < I3) { p0_transpose_item(w_pg + (size_t)l * DM * DM, DM, DM, DM, 0, nullptr, WPG + (size_t)l * DM * DM, scr, r, F.lane); continue; } r -= I3;
          p0_transpose_item(w_pe + (size_t)l * PLE * DM, PLE, DM, DM, 0, nullptr, WPE + (size_t)l * DM * PLE, scr, r, F.lane);
      }
      for (int i = (F.vcu * NWAVES + F.wave) * 64 + F.lane; i < DEPTH * 16 * DM; i += NGW * 64) { const int l = i / (16 * DM), r = i % (16 * DM), n = r / DM, k = r % DM;
          WF[i] = (bf16_t)f2bf(norm_pre[l * DM + k] * w_in[(size_t)l * DM * INC + (size_t)k * INC + 4096 + n]); }
      for (int m = gw; m < T; m += NGW) {
          const GAS f32x4* xr = (const GAS f32x4*)(x + (size_t)m * DM) + F.lane; float s = 0.f; f32x4 v[4];
#pragma unroll
          for (int j = 0; j < 4; ++j) { v[j] = xr[64 * j]; s += (v[j].x * v[j].x + v[j].y * v[j].y) + (v[j].z * v[j].z + v[j].w * v[j].w); }
          s = wave_sum(s);
          GAS u32x2* o = (GAS u32x2*)(HB + (size_t)m * DM) + F.lane;
#pragma unroll
          for (int j = 0; j < 4; ++j) { u32x2 w; w.x = pk2(v[j].x, v[j].y); w.y = pk2(v[j].z, v[j].w); o[64 * j] = w; }
          if (F.lane == 0) { RSS[m] = s; RSS[T + m] = 0.f; }
      }
    }
}
__device__ __forceinline__ void p1_flogit(Frame& F, const bf16_t* HB, const bf16_t* WFl, const float* rss, const float* bfv, float* LF) {
    const int gw = F.vcu * NWAVES + F.wave, NGW = F.G * NWAVES, fr = F.lane & 15, fq = F.lane >> 4;
    for (int task = gw; task < T / 16; task += NGW) {
        const int t0 = task * 16; f32x4 acc = (f32x4){0.f, 0.f, 0.f, 0.f};
        const bf16_t* hrow = HB + (size_t)(t0 + fr) * DM + 8 * fq; const bf16_t* wrow = WFl + (size_t)fr * DM + 8 * fq;
#pragma unroll 8
        for (int ks = 0; ks < DM / 32; ++ks) { const bf16x8 av = *(const GAS bf16x8*)(wrow + 32 * ks), bv = *(const GAS bf16x8*)(hrow + 32 * ks);
            acc = __builtin_amdgcn_mfma_f32_16x16x32_bf16(av, bv, acc, 0, 0, 0); }
        const int t = t0 + fr, b = t / SEQ, sq = t % SEQ; const float rstd = rsqrtf(rss[t] * (1.f / DM) + EPS);
#pragma unroll
        for (int r = 0; r < 4; ++r) { const int hd = 4 * fq + r; const float xv = acc[r] * rstd + bfv[hd];
            LF[((size_t)(b * NH + hd)) * SEQ + sq] = fminf(xv, 0.f) - log1pf(__expf(-fabsf(xv))); }
    }
}
__device__ __forceinline__ void p2_pool(Frame& F, const bf16_t* Y, bf16_t* QZ) {
    const int rows_per = T / F.G;
    const int cg = F.tid & 127, c = cg * 8, w = 2 << (c >> 8);
    for (int rb = (F.tid >> 7) * 32; rb < rows_per; rb += 128) {
        const int t0 = F.vcu * rows_per + rb, s0 = t0 % SEQ;
        float sum[8];
#pragma unroll
        for (int e = 0; e < 8; ++e) sum[e] = 0.f;
        for (int j = 1; j < w; ++j) if (s0 - j >= 0) { const u32x4 v = *(const GAS u32x4*)(Y + (size_t)(t0 - j) * DM + c);
            sum[0] += bflo(v.x); sum[1] += bfhi(v.x); sum[2] += bflo(v.y); sum[3] += bfhi(v.y); sum[4] += bflo(v.z); sum[5] += bfhi(v.z); sum[6] += bflo(v.w); sum[7] += bfhi(v.w); }
        for (int i = 0; i < 32; ++i) {
            const int t = t0 + i, s = s0 + i;
            const u32x4 v = *(const GAS u32x4*)(Y + (size_t)t * DM + c);
            const float yt[8] = {bflo(v.x), bfhi(v.x), bflo(v.y), bfhi(v.y), bflo(v.z), bfhi(v.z), bflo(v.w), bfhi(v.w)};
            bf16_t* zp = QZ + (size_t)t * 2048 + 1024 + c; const u32x4 z = *(const GAS u32x4*)zp;
            const float zf[8] = {bflo(z.x), bfhi(z.x), bflo(z.y), bfhi(z.y), bflo(z.z), bfhi(z.z), bflo(z.w), bfhi(z.w)};
            const int cnt = (s + 1 < w) ? s + 1 : w; const float ic = 1.f / (float)cnt; float r[8];
#pragma unroll
            for (int e = 0; e < 8; ++e) { sum[e] += yt[e]; r[e] = (sum[e] * ic - yt[e]) * zf[e]; }
            u32x4 o; o.x = pk2(r[0], r[1]); o.y = pk2(r[2], r[3]); o.z = pk2(r[4], r[5]); o.w = pk2(r[6], r[7]); *(GAS u32x4*)zp = o;
            if (s - w + 1 >= 0) { const u32x4 u = *(const GAS u32x4*)(Y + (size_t)(t - w + 1) * DM + c);
                sum[0] -= bflo(u.x); sum[1] -= bfhi(u.x); sum[2] -= bflo(u.y); sum[3] -= bfhi(u.y); sum[4] -= bflo(u.z); sum[5] -= bfhi(u.z); sum[6] -= bflo(u.w); sum[7] -= bfhi(u.w); }
        }
    }
}
__device__ __forceinline__ void p2_cvt_p(Frame& F, const float* p, bf16_t* PB) {
    const size_t n8 = (size_t)T * PLE / 8;
    for (size_t i = (size_t)F.vcu * 512 + F.tid; i < n8; i += (size_t)F.G * 512) { const f32x4 a = ((const GAS f32x4*)p)[2 * i], b = ((const GAS f32x4*)p)[2 * i + 1];
        u32x4 o; o.x = pk2(a.x, a.y); o.y = pk2(a.z, a.w); o.z = pk2(b.x, b.y); o.w = pk2(b.z, b.w); ((GAS u32x4*)PB)[i] = o; }
}
__device__ __forceinline__ void p3_rmspost(Frame& F, const float* mix, const float* base, const float* gp, float* out, bf16_t* hb) {
    const int gw = F.vcu * NWAVES + F.wave, NGW = F.G * NWAVES;
    for (int m = gw; m < T; m += NGW) {
        const GAS f32x4* xr = (const GAS f32x4*)(mix + (size_t)m * DM) + F.lane; float s = 0.f; f32x4 v[4];
#pragma unroll
        for (int j = 0; j < 4; ++j) { v[j] = xr[64 * j]; s += (v[j].x * v[j].x + v[j].y * v[j].y) + (v[j].z * v[j].z + v[j].w * v[j].w); }
        const float rstd = rsqrtf(wave_sum(s) * (1.f / DM) + EPS);
#pragma unroll
        for (int j = 0; j < 4; ++j) { const f32x4 bs = ((const GAS f32x4*)(base + (size_t)m * DM) + F.lane)[64 * j]; const f32x4 gg = ((const GAS f32x4*)gp + F.lane)[64 * j];
            const f32x4 r = bs + v[j] * rstd * gg; ((GAS f32x4*)(out + (size_t)m * DM) + F.lane)[64 * j] = r;
            u32x2 w; w.x = pk2(r.x, r.y); w.y = pk2(r.z, r.w); ((GAS u32x2*)(hb + (size_t)m * DM) + F.lane)[64 * j] = w; }
    }
}

__global__ void __launch_bounds__(NWAVES * 64, 2) mk_fwd(Args args) {
    extern __shared__ __attribute__((aligned(16))) unsigned char lds[];
    Frame F;
    F.lds = (LAS unsigned char*)lds; F.MISC = (volatile LAS unsigned*)(F.lds + MISC_OFF);
    F.tid = threadIdx.x; F.lane = F.tid & 63; F.wave = __builtin_amdgcn_readfirstlane(F.tid >> 6);
    F.G = NCU; { const int bx = blockIdx.x; F.vcu = (bx % 8) * (NCU / 8) + bx / 8; }
    unsigned char* ws = args.ws; F.ctl = (gu32*)(ws + WS_CTL);
    for (int u = F.tid; u < (LDS_BYTES - LDSCTL_OFF) / 4; u += NWAVES * 64) ((LAS unsigned*)(F.lds + LDSCTL_OFF))[u] = 0u;
    __syncthreads();
    XcdBarrier bar = xcd_barrier_post((unsigned*)(F.ctl + CW_BAR) + args.li * BAR_STRIDE, F.MISC + 8);
    float* out = args.out;
    float* LF = (float*)(ws + WS_LF); float* RSS = (float*)(ws + WS_RSS);
    bf16_t* HB = (bf16_t*)(ws + WS_HB); bf16_t* QZ = (bf16_t*)(ws + WS_QZ); bf16_t* KB = (bf16_t*)(ws + WS_K); bf16_t* VB = (bf16_t*)(ws + WS_V); bf16_t* ZA = (bf16_t*)(ws + WS_ZA); bf16_t* YB = (bf16_t*)(ws + WS_Y);
    float* MIX = (float*)(ws + WS_MIX); bf16_t* H1B = ZA; bf16_t* PE = YB; bf16_t* PB = HB;
    for (int ph = args.ph_lo; ph < args.ph_hi; ++ph) {
        { int t_ = threadIdx.x; asm volatile("" : "+v"(t_)); F.tid = t_; F.lane = t_ & 63; }
        if (ph == 0) { if (MK_CODE & 1) p0_prologue(F, args); }
        else {
            const int l = (ph - 1) / 5, k = (ph - 1) % 5;
            const float* rss = RSS + (size_t)l * T;
            if (k == 0 && (MK_CODE & 2)) {
                p1_flogit(F, HB, (const bf16_t*)(ws + WS_WF) + (size_t)l * 16 * DM, rss, args.in[5] + l * NH, LF);
                pg8::Gemm g{HB, (const bf16_t*)(ws + WS_WIN) + (size_t)l * NIN * DM, T, NIN, DM}; pg8::StaticOrder S; S.init(T, NIN, F.G, (int)blockIdx.x);
                pg8::EpiIn E{rss, QZ, KB, VB, ZA, YB, args.in[7] + l * 1024};
                pg8::gemm_phase<pg8::EpiIn, pg8::StaticOrder, true, true>(F.lds + RING_OFF, g, S, E);
            } else if (k == 1 && (MK_CODE & 4)) {
                const attn_body::AttnTensors AT{(const attn_body::bf16*)QZ, (const attn_body::bf16*)KB, (const attn_body::bf16*)VB, (const attn_body::bf16*)ZA, (attn_body::bf16*)QZ, LF};
                attn_body::attn_phase<8>((char*)lds + RING_OFF, AT, F.vcu, F.G);
                p2_pool(F, YB, QZ);
                p2_cvt_p(F, args.in[1] + (size_t)l * T * PLE, PB);
            } else if (k == 2 && (MK_CODE & 8)) {
                { int kpe = PLE; asm volatile("" : "+s"(kpe));
                  pg8::Gemm g{PB, (const bf16_t*)(ws + WS_WPE) + (size_t)l * DM * PLE, T, DM, kpe}; pg8::StaticOrder S; S.init(T, DM, F.G, (int)blockIdx.x);
                  pg8::EpiBf16 E{PE, DM}; pg8::gemm_phase<pg8::EpiBf16, pg8::StaticOrder, true, true>(F.lds + RING_OFF, g, S, E); }
                { pg8::Gemm g{QZ, (const bf16_t*)(ws + WS_WOUT) + (size_t)l * DM * MIXW, T, DM, MIXW}; pg8::StaticOrder S; S.init(T, DM, F.G, (int)blockIdx.x);
                  pg8::EpiF32 E{MIX, DM}; pg8::gemm_phase<pg8::EpiF32, pg8::StaticOrder, true, true>(F.lds + RING_OFF, g, S, E); }
            } else if (k == 3 && (MK_CODE & 16)) {
                p3_rmspost(F, MIX, l == 0 ? args.in[0] : out, args.in[3] + l * DM, out, H1B);
            } else if (k == 4 && (MK_CODE & 32)) {
                pg8::Gemm g{H1B, (const bf16_t*)(ws + WS_WPG) + (size_t)l * DM * DM, T, DM, DM}; pg8::StaticOrder S; S.init(T, DM, F.G, (int)blockIdx.x);
                pg8::EpiGate E{out, PE, HB, (l + 1 < DEPTH) ? RSS + (size_t)(l + 1) * T : nullptr};
                pg8::gemm_phase<pg8::EpiGate, pg8::StaticOrder, true, true>(F.lds + RING_OFF, g, S, E);
            }
        }
        if (ph + 1 < args.ph_hi) xcd_barrier(bar);
    }
}
extern "C" void kernel_launch(void* const* d_in, const int* in_sizes, int n_in, void* d_out, int out_size, void* d_ws, size_t ws_size, hipStream_t stream) {
    static int grid = 0;
    if (grid == 0) {
        if (n_in != 11 || in_sizes[0] != T * DM || out_size != T * DM || ws_size < WS_END) { fprintf(stderr, "kernel_launch: unexpected shapes (n_in %d, in0 %d, out %d, ws %zu)\n", n_in, n_in > 0 ? in_sizes[0] : -1, out_size, ws_size); grid = -1; return; }
        int dev = 0, cus = 0, per_cu = 0;
        if (hipGetDevice(&dev) != hipSuccess || hipDeviceGetAttribute(&cus, hipDeviceAttributeMultiprocessorCount, dev) != hipSuccess) { fprintf(stderr, "kernel_launch: device query failed\n"); grid = -1; return; }
        if (hipFuncSetAttribute((const void*)mk_fwd, hipFuncAttributeMaxDynamicSharedMemorySize, LDS_BYTES) != hipSuccess) { fprintf(stderr, "kernel_launch: hipFuncSetAttribute failed\n"); grid = -1; return; }
        if (hipOccupancyMaxActiveBlocksPerMultiprocessor(&per_cu, (const void*)mk_fwd, NWAVES * 64, LDS_BYTES) != hipSuccess || per_cu < 1) { fprintf(stderr, "kernel_launch: occupancy query reports %d workgroups per CU\n", per_cu); (void)hipGetLastError(); per_cu = 1; }
        if (cus < NCU) { fprintf(stderr, "kernel_launch: built for a %d-CU device, found %d CUs; nothing launched\n", NCU, cus); grid = -1; return; }
        grid = NCU * (per_cu < 1 ? 1 : 1);
    }
    if (grid < 0) return;
    const float* x = (const float*)d_in[0]; const float* p = (const float*)d_in[1]; const float* norm_pre = (const float*)d_in[2]; const float* norm_post = (const float*)d_in[3];
    const float* w_in = (const float*)d_in[4]; const float* b_f = (const float*)d_in[5]; const float* w_pool = (const float*)d_in[6]; const float* pool_scale = (const float*)d_in[7];
    const float* w_out = (const float*)d_in[8]; const float* w_pg = (const float*)d_in[9]; const float* w_pe = (const float*)d_in[10];
    float* out = (float*)d_out; unsigned char* ws = (unsigned char*)d_ws;
    float* LF = (float*)(ws + WS_LF); float* CS = (float*)(ws + WS_CS); float* RSS = (float*)(ws + WS_RSS);
    bf16_t* WIN = (bf16_t*)(ws + WS_WIN); bf16_t* WF = (bf16_t*)(ws + WS_WF); bf16_t* WOUT = (bf16_t*)(ws + WS_WOUT); bf16_t* WPG = (bf16_t*)(ws + WS_WPG); bf16_t* WPE = (bf16_t*)(ws + WS_WPE);
    bf16_t* HB = (bf16_t*)(ws + WS_HB); bf16_t* QZ = (bf16_t*)(ws + WS_QZ); bf16_t* KB = (bf16_t*)(ws + WS_K); bf16_t* VB = (bf16_t*)(ws + WS_V); bf16_t* ZA = (bf16_t*)(ws + WS_ZA); bf16_t* YB = (bf16_t*)(ws + WS_Y);
    float* MIX = (float*)(ws + WS_MIX); bf16_t* H1B = ZA; bf16_t* PE = YB; bf16_t* PB = HB;
    if (hipMemsetAsync((char*)d_ws + WS_CTL, 0, CTL_ZERO_BYTES, stream) != hipSuccess) { fprintf(stderr, "kernel_launch: hipMemsetAsync failed\n"); return; }
    Args a{};
    for (int i = 0; i < 11; ++i) a.in[i] = (const float*)d_in[i];
    a.out = out; a.ws = ws;
    int li = 0;
    for (int ph = 0; ph < NPHASE;) {
        if ((MK_MASK >> ph) & 1) {
            int hi = ph; while (hi < NPHASE && ((MK_MASK >> hi) & 1)) ++hi;
            a.ph_lo = ph; a.ph_hi = hi; a.li = li++;
            hipLaunchKernelGGL(mk_fwd, dim3(grid), dim3(NWAVES * 64), LDS_BYTES, stream, a);
            const hipError_t le = hipPeekAtLastError(); if (le != hipSuccess) { fprintf(stderr, "kernel_launch: launch failed: %s\n", hipGetErrorName(le)); return; }
            ph = hi; continue;
        }
#if MK_MASK != 0x7FF
        if (ph == 0) {
            for (int l = 0; l < DEPTH; ++l) {
                const float* wi = w_in + (size_t)l * DM * INC; const float* gpre = norm_pre + l * DM; bf16_t* wt = WIN + (size_t)l * NIN * DM;
                k_transpose<<<1024, 256, 0, stream>>>(wi, DM, 4096, INC, 0, gpre, wt);
                k_transpose<<<512, 256, 0, stream>>>(wi, DM, 1024, INC, 5136, gpre, wt + (size_t)5120 * DM);
                k_poolfold<<<dim3(4, 16, 4), 256, 0, stream>>>(wi, w_pool + (size_t)l * 4 * 256 * 256, gpre, wt);
                k_fcols<<<64, 256, 0, stream>>>(wi, gpre, WF + (size_t)l * 16 * DM);
                k_transpose<<<512, 256, 0, stream>>>(w_out + (size_t)l * MIXW * DM, MIXW, DM, DM, 0, nullptr, WOUT + (size_t)l * DM * MIXW);
                k_transpose<<<512, 256, 0, stream>>>(w_pg + (size_t)l * DM * DM, DM, DM, DM, 0, nullptr, WPG + (size_t)l * DM * DM);
                k_transpose<<<128, 256, 0, stream>>>(w_pe + (size_t)l * PLE * DM, PLE, DM, DM, 0, nullptr, WPE + (size_t)l * DM * PLE);
            }
            k_rows_bf16<<<2048, 256, 0, stream>>>(x, HB, RSS, T);
            hipMemsetAsync(RSS + T, 0, (size_t)T * 4, stream);
        } else {
            const int l = (ph - 1) / 5, k = (ph - 1) % 5; const float* rss = RSS + (size_t)l * T;
            if (k == 0) {
                V1EpiIn ein{rss, QZ, KB, VB, ZA, YB, pool_scale + l * 1024};
                k_gemm<V1EpiIn><<<dim3(NIN / 128, T / 128), 256, 0, stream>>>(HB, DM, WIN + (size_t)l * NIN * DM, DM, DM, ein);
                k_flogit<<<T / 16, 256, 0, stream>>>(HB, WF + (size_t)l * 16 * DM, rss, b_f + l * NH, LF);
            } else if (k == 1) {
                k_scan<<<BATCH * NH, 256, 0, stream>>>(LF, CS);
                k_attn<<<dim3(SEQ / 64, NH, BATCH), 256, 0, stream>>>(QZ, KB, VB, ZA, CS);
                k_pool<<<T * 128 / 256, 256, 0, stream>>>(YB, QZ);
                k_cvt<<<2048, 256, 0, stream>>>(p + (size_t)l * T * PLE, PB, (size_t)T * PLE / 4);
            } else if (k == 2) {
                V1EpiBf epe{PE, DM};
                k_gemm<V1EpiBf><<<dim3(DM / 128, T / 128), 256, 0, stream>>>(PB, PLE, WPE + (size_t)l * DM * PLE, PLE, PLE, epe);
                V1EpiF32 emix{MIX, DM};
                k_gemm<V1EpiF32><<<dim3(DM / 128, T / 128), 256, 0, stream>>>(QZ, 2048, WOUT + (size_t)l * DM * MIXW, MIXW, MIXW, emix);
            } else if (k == 3) {
                k_rmspost<<<2048, 256, 0, stream>>>(MIX, l == 0 ? x : out, norm_post + l * DM, out, H1B);
            } else {
                V1EpiGate eg{out, PE, HB};
                k_gemm<V1EpiGate><<<dim3(DM / 128, T / 128), 256, 0, stream>>>(H1B, DM, WPG + (size_t)l * DM * DM, DM, DM, eg);
                if (l + 1 < DEPTH) k_rows_bf16<<<2048, 256, 0, stream>>>(out, nullptr, RSS + (size_t)(l + 1) * T, T);
            }
        }
#endif
        ++ph;
    }
}
```
